# Optimizing an MI355X kernel written in HIP

```python
import jax
import jax.numpy as jnp
from jax import lax
import numpy as np

D_MODEL = 2048
BATCH = 4
SEQ = 8192
DEPTH = 1

CTX_LEN = 256
GRID_W = 64
WIN_H = 8
WIN_W = 16
NA_HEADS = 16
NA_HEAD_DIM = 64
NA_WIDTH = NA_HEADS * NA_HEAD_DIM
HG_HEADS = 8
HG_KEY_DIM = 128
HG_VAL_DIM = 128
HG_FDIM = HG_HEADS * HG_KEY_DIM
HG_WIDTH = HG_HEADS * HG_VAL_DIM
HG_CHUNK = 64
FFN_HIDDEN = -(-8 * D_MODEL // (3 * 256)) * 256
N_MOD = 6
EPS = 1e-6
IN_SPLIT = (NA_WIDTH, NA_WIDTH, NA_WIDTH, HG_FDIM, HG_FDIM, HG_FDIM, HG_WIDTH, HG_WIDTH, D_MODEL, D_MODEL)
IN_WIDTH = sum(IN_SPLIT)

kernel_name = 'hybrid_natten_hgrn2_dit_layer'


def rmsnorm(x, g):
    xf = x.astype(jnp.float32)
    y = xf * lax.rsqrt(jnp.mean(xf * xf, axis=-1, keepdims=True) + EPS)
    return (y * g.astype(jnp.float32)).astype(x.dtype)


def modulate(h, shift, scale):
    return h * (1 + scale) + shift


def split_columns(u):
    cuts, acc = [], 0
    for w in IN_SPLIT[:-1]:
        acc += w
        cuts.append(acc)
    return jnp.split(u, cuts, axis=-1)


def to_heads(a, n_heads):
    return a.reshape(a.shape[0], a.shape[1], n_heads, -1)


def neighbourhood_attention(q, k, v, k_ctx, v_ctx, rpb):
    b, s, h, dh = q.shape
    rows = s // GRID_W
    kh = min(WIN_H, rows)
    scale = dh ** -0.5
    qg = q.reshape(b, rows, GRID_W, h, dh)
    kg = k.reshape(b, rows, GRID_W, h, dh)
    vg = v.reshape(b, rows, GRID_W, h, dh)
    col = jnp.arange(GRID_W)
    col_start = jnp.clip(col - WIN_W // 2, 0, GRID_W - WIN_W)
    in_win = (col[None, :] >= col_start[:, None]) & (col[None, :] < col_start[:, None] + WIN_W)
    band_mask = jnp.broadcast_to(in_win[:, None, :], (GRID_W, kh, GRID_W)).reshape(GRID_W, kh * GRID_W)
    dc_idx = jnp.clip(col[None, :] - col[:, None], 1 - WIN_W, WIN_W - 1) + WIN_W - 1
    row_start = jnp.clip(jnp.arange(rows) - kh // 2, 0, rows - kh)
    nb = kh * GRID_W

    def one_row(r):
        rs = row_start[r]
        q_r = lax.dynamic_index_in_dim(qg, r, axis=1, keepdims=False)
        k_band = lax.dynamic_slice_in_dim(kg, rs, kh, axis=1).reshape(b, nb, h, dh)
        v_band = lax.dynamic_slice_in_dim(vg, rs, kh, axis=1).reshape(b, nb, h, dh)
        dr_idx = rs + jnp.arange(kh) - r + WIN_H - 1
        bias = rpb[:, dr_idx][:, :, dc_idx]
        bias = bias.transpose(0, 2, 1, 3).reshape(h, GRID_W, nb).astype(jnp.float32)
        s_band = jnp.einsum('bqhd,bnhd->bhqn', q_r, k_band, preferred_element_type=jnp.float32) * scale + bias
        s_band = jnp.where(band_mask, s_band, -jnp.inf)
        s_ctx = jnp.einsum('bqhd,bmhd->bhqm', q_r, k_ctx, preferred_element_type=jnp.float32) * scale
        p = jax.nn.softmax(jnp.concatenate([s_band, s_ctx], axis=-1), axis=-1).astype(v.dtype)
        return (jnp.einsum('bhqn,bnhd->bqhd', p[..., :nb], v_band)
                + jnp.einsum('bhqm,bmhd->bqhd', p[..., nb:], v_ctx))

    out = lax.map(one_row, jnp.arange(rows))
    return out.transpose(1, 0, 2, 3, 4).reshape(b, s, h * dh)


def context_attention(q, k, v):
    b, l, h, dh = q.shape
    s = jnp.einsum('blhd,bmhd->bhlm', q, k, preferred_element_type=jnp.float32) * dh ** -0.5
    p = jax.nn.softmax(s, axis=-1).astype(v.dtype)
    return jnp.einsum('bhlm,bmhd->blhd', p, v).reshape(b, l, h * dh)


def hgrn2_gates(f_logits, lb):
    f = lb + (1 - lb) * jax.nn.sigmoid(f_logits.astype(jnp.float32))
    return jnp.log(f), 1 - f


def hgrn2_chunk_scan(q, k, log_f, v, state0):
    b, t, h, dk = q.shape
    dv = v.shape[-1]
    n = t // HG_CHUNK

    def chunks(a):
        return a.astype(jnp.float32).reshape(b, n, HG_CHUNK, h, a.shape[-1]).transpose(1, 0, 3, 2, 4)

    tri = jnp.tril(jnp.ones((HG_CHUNK, HG_CHUNK), dtype=bool))[:, :, None]

    def step(state, inp):
        q_c, k_c, lf_c, v_c = inp
        cum = jnp.cumsum(lf_c, axis=2)
        rel = jnp.exp(jnp.where(tri, cum[:, :, :, None, :] - cum[:, :, None, :, :], -jnp.inf))
        attn = jnp.einsum('bhtk,bhsk,bhtsk->bhts', q_c, k_c, rel)
        out = (jnp.einsum('bhts,bhsv->bhtv', attn, v_c)
               + jnp.einsum('bhtk,bhkv->bhtv', q_c * jnp.exp(cum), state))
        last = cum[:, :, -1:, :]
        new_state = (jnp.exp(last[:, :, 0, :])[..., None] * state
                     + jnp.einsum('bhsk,bhsv->bhkv', k_c * jnp.exp(last - cum), v_c))
        return new_state, out

    final, out = lax.scan(step, state0, (chunks(q), chunks(k), chunks(log_f), chunks(v)))
    return out.transpose(1, 0, 3, 2, 4).reshape(b, t, h, dv), final


def hgrn2_bidirectional(q, f_fwd, f_bwd, i, lb_fwd, lb_bwd, state_fwd, state_bwd):
    lf1, k1 = hgrn2_gates(f_fwd, lb_fwd)
    lf2, k2 = hgrn2_gates(f_bwd, lb_bwd)
    o1, s1 = hgrn2_chunk_scan(q, k1, lf1, i, state_fwd)
    o2, s2 = hgrn2_chunk_scan(jnp.flip(q, 1), jnp.flip(k2, 1), jnp.flip(lf2, 1), jnp.flip(i, 1), state_bwd)
    return o1 + jnp.flip(o2, 1), s1, s2


def hgrn2_readout(o, out_gate, g):
    on = o * lax.rsqrt(jnp.mean(o * o, axis=-1, keepdims=True) + EPS) * g.astype(jnp.float32)
    on = on.reshape(o.shape[0], o.shape[1], -1)
    return (on * jax.nn.silu(out_gate.astype(jnp.float32))).astype(out_gate.dtype)


def gated_merge(o_a, o_b, gate_a, gate_b, w_pa, w_pb, w_out):
    y = jax.nn.sigmoid(gate_a) * (o_a @ w_pa) + jax.nn.sigmoid(gate_b) * (o_b @ w_pb)
    return y @ w_out


def swiglu(h, w_in, w_out):
    a, u = jnp.split(h @ w_in, 2, axis=-1)
    return (jax.nn.silu(a) * u) @ w_out


def token_mixing(h, hc, w_in, rpb, lb_f, lb_b, hg_g, w_pa, w_pb, w_out, with_ctx_out):
    q, k, v, hq, hf_f, hf_b, hi, hog, ga, gb = split_columns(h @ w_in)
    qc, kc, vc, hqc, hfc_f, hfc_b, hic, hogc, gac, gbc = split_columns(hc @ w_in)
    b = hc.shape[0]
    kc_h, vc_h = to_heads(kc, NA_HEADS), to_heads(vc, NA_HEADS)
    o_na = neighbourhood_attention(to_heads(q, NA_HEADS), to_heads(k, NA_HEADS), to_heads(v, NA_HEADS),
                                   kc_h, vc_h, rpb)
    zero = jnp.zeros((b, HG_HEADS, HG_KEY_DIM, HG_VAL_DIM), jnp.float32)
    oc_hg, s_f, s_b = hgrn2_bidirectional(to_heads(hqc, HG_HEADS), to_heads(hfc_f, HG_HEADS),
                                          to_heads(hfc_b, HG_HEADS), to_heads(hic, HG_HEADS),
                                          lb_f, lb_b, zero, zero)
    o_hg, _, _ = hgrn2_bidirectional(to_heads(hq, HG_HEADS), to_heads(hf_f, HG_HEADS),
                                     to_heads(hf_b, HG_HEADS), to_heads(hi, HG_HEADS),
                                     lb_f, lb_b, s_f, s_b)
    y = gated_merge(o_na, hgrn2_readout(o_hg, hog, hg_g), ga, gb, w_pa, w_pb, w_out)
    yc = None
    if with_ctx_out:
        oc_na = context_attention(to_heads(qc, NA_HEADS), kc_h, vc_h)
        yc = gated_merge(oc_na, hgrn2_readout(oc_hg, hogc, hg_g), gac, gbc, w_pa, w_pb, w_out)
    return y, yc


def setup_inputs(seed: int = 0) -> dict:
    key = jax.random.key(seed)
    ks = jax.random.split(key, 20)
    f32 = jnp.float32

    def nrm(k, shape, scale):
        return jax.random.normal(k, shape, f32) * scale

    return {
        'x': nrm(ks[0], (BATCH, SEQ, D_MODEL), 1.0),
        'c': nrm(ks[1], (BATCH, D_MODEL), 1.0),
        'ctx': nrm(ks[2], (BATCH, CTX_LEN, D_MODEL), 1.0),
        'c_ctx': nrm(ks[3], (D_MODEL,), 1.0),
        'w_ada': nrm(ks[4], (DEPTH, D_MODEL, N_MOD * D_MODEL), 0.5 * D_MODEL ** -0.5),
        'b_ada': nrm(ks[5], (DEPTH, N_MOD * D_MODEL), 0.01),
        'norm1_g': 1.0 + nrm(ks[6], (DEPTH, D_MODEL), 0.02),
        'w_in': nrm(ks[7], (DEPTH, D_MODEL, IN_WIDTH), D_MODEL ** -0.5),
        'na_rpb': nrm(ks[8], (DEPTH, NA_HEADS, 2 * WIN_H - 1, 2 * WIN_W - 1), 0.1),
        'hg_lb_logits': nrm(ks[9], (DEPTH + 1, 2, HG_FDIM), 1.0),
        'hg_norm_g': 1.0 + nrm(ks[10], (DEPTH, HG_VAL_DIM), 0.02),
        'w_pa': nrm(ks[11], (DEPTH, NA_WIDTH, D_MODEL), NA_WIDTH ** -0.5),
        'w_pb': nrm(ks[12], (DEPTH, HG_WIDTH, D_MODEL), HG_WIDTH ** -0.5),
        'w_out': nrm(ks[13], (DEPTH, D_MODEL, D_MODEL), D_MODEL ** -0.5),
        'norm2_g': 1.0 + nrm(ks[14], (DEPTH, D_MODEL), 0.02),
        'w_ffn_in': nrm(ks[15], (DEPTH, D_MODEL, 2 * FFN_HIDDEN), D_MODEL ** -0.5),
        'w_ffn_out': nrm(ks[16], (DEPTH, FFN_HIDDEN, D_MODEL), FFN_HIDDEN ** -0.5),
        'final_g': 1.0 + nrm(ks[17], (D_MODEL,), 0.02),
    }


def reference(x, c, ctx, c_ctx, w_ada, b_ada, norm1_g, w_in, na_rpb, hg_lb_logits, hg_norm_g,
              w_pa, w_pb, w_out, norm2_g, w_ffn_in, w_ffn_out, final_g):
    b = x.shape[0]
    lb_table = jnp.cumsum(jax.nn.softmax(hg_lb_logits.astype(jnp.float32), axis=0), axis=0)
    silu_c = jax.nn.silu(c)
    silu_cc = jax.nn.silu(c_ctx)
    xc = ctx
    for l in range(DEPTH):
        last = l == DEPTH - 1
        mod = (silu_c @ w_ada[l] + b_ada[l]).reshape(b, N_MOD, 1, D_MODEL)
        mod_c = (silu_cc @ w_ada[l] + b_ada[l]).reshape(N_MOD, 1, D_MODEL)
        sh1, sc1, g1, sh2, sc2, g2 = [mod[:, j] for j in range(N_MOD)]
        sh1c, sc1c, g1c, sh2c, sc2c, g2c = [mod_c[j] for j in range(N_MOD)]
        lb_f = lb_table[l, 0].reshape(HG_HEADS, HG_KEY_DIM)
        lb_b = lb_table[l, 1].reshape(HG_HEADS, HG_KEY_DIM)
        h = modulate(rmsnorm(x, norm1_g[l]), sh1, sc1)
        hc = modulate(rmsnorm(xc, norm1_g[l]), sh1c, sc1c)
        y, yc = token_mixing(h, hc, w_in[l], na_rpb[l], lb_f, lb_b, hg_norm_g[l],
                             w_pa[l], w_pb[l], w_out[l], not last)
        x = x + g1 * y
        x = x + g2 * swiglu(modulate(rmsnorm(x, norm2_g[l]), sh2, sc2), w_ffn_in[l], w_ffn_out[l])
        if not last:
            xc = xc + g1c * yc
            xc = xc + g2c * swiglu(modulate(rmsnorm(xc, norm2_g[l]), sh2c, sc2c), w_ffn_in[l], w_ffn_out[l])
    return rmsnorm(x, final_g)
```

```cpp
#include <hip/hip_runtime.h>
#include <hip/hip_cooperative_groups.h>
#include <cstdio>
#include <cstdint>
namespace cg = cooperative_groups;
namespace pg8 {
#define PG8_LAS __attribute__((address_space(3)))
typedef unsigned short bf16_t;
typedef short bf16x8 __attribute__((ext_vector_type(8)));
typedef float f32x4 __attribute__((ext_vector_type(4)));
typedef unsigned u32x4 __attribute__((ext_vector_type(4)));
constexpr int BM = 256, BK = 64, HALF = 128, HTB = HALF * BK * 2  , STAGE_BYTES = 8 * HTB, NXCD = 8, WGM = 8;

__host__ __device__ __forceinline__ int lds_byte(int r, int c) { const int st = (r >> 4) * 2 + (c >> 5), rr = r & 15, cc = c & 31, ob = rr * 64 + cc * 2; return st * 1024 + (ob ^ (((ob >> 9) & 1) << 5)); }
__host__ __device__ __forceinline__ void stage_rc(int b, int& R, int& C) { const int st = b / 1024, sb = b % 1024, swz = sb ^ (((sb >> 9) & 1) << 5); R = (st >> 1) * 16 + swz / 64; C = (st & 1) * 32 + (swz % 64) / 2; }
__host__ __device__ __forceinline__ int perm32(int rho) { const int n = rho >> 4, i = rho & 15; return 8 * (i >> 2) + 4 * n + (i & 3); }

struct Unit { int pm, pn; };
struct Gemm { const bf16_t* A; const bf16_t* Bt; int M, N, K; };

struct StaticOrder {
    int nM, nN, nwg, G, c, base, lim;
    __host__ __device__ void init(int M, int N, int G_, int c_) { nM = M / BM; nN = N / BM; nwg = nM * nN; G = G_; c = c_; base = 0; lim = nwg; }
    __host__ __device__ void init2(int M, int N, int G_, int c_, int base_, int lim_) { init(M, N, G_, c_); base = base_; lim = lim_ < nwg ? lim_ : nwg; }
    __host__ __device__ bool next(int i, Unit& u) const {
        const long L = (long)base + (long)i * G + c; if (L >= lim) return false;
        int wgid = (int)L; { const int q = nwg / NXCD, r = nwg % NXCD, xcd = wgid % NXCD, off = wgid / NXCD; wgid = (xcd < r ? xcd * (q + 1) : r * (q + 1) + (xcd - r) * q) + off; }
        const int nig = WGM * nN, gid = wgid / nig, fm = gid * WGM, gsz = (nM - fm) < WGM ? (nM - fm) : WGM;
        u.pm = fm + ((wgid % nig) % gsz); u.pn = (wgid % nig) / gsz; return true;
    }
    __device__ __forceinline__ void a_ready(const Unit&) const {}
    __device__ __forceinline__ void done(const Unit&) const {}
};

__device__ __forceinline__ unsigned cvt_pk_bf16(float lo, float hi) { unsigned r; asm volatile("v_cvt_pk_bf16_f32 %0, %1, %2" : "=v"(r) : "v"(lo), "v"(hi)); return r; }
typedef float f32x2c __attribute__((ext_vector_type(2))); typedef __bf16 bf16x2c __attribute__((ext_vector_type(2)));
__device__ __forceinline__ unsigned cvt_pk_bf16_c(float lo, float hi) { f32x2c v = {lo, hi}; bf16x2c b = __builtin_convertvector(v, bf16x2c); return __builtin_bit_cast(unsigned, b); }
__device__ __forceinline__ float bflo(unsigned u) { return __uint_as_float(u << 16); }
__device__ __forceinline__ float bfhi(unsigned u) { return __uint_as_float(u & 0xffff0000u); }
__device__ __forceinline__ float sigm(float x) { return __builtin_amdgcn_rcpf(1.0f + __expf(-x)); }
struct EpiStore {
    static constexpr bool PERM = true, AFTER_DRAIN = false;
    bf16_t* O; int ldc; bf16_t* HM; int hm_lo, hm_hi, hm_rows, mode; const float* lbl; int g_lo, g_hi;
    __device__ __forceinline__ void operator()(const f32x4 (&acc)[2][2][4][2], const Unit& u, int wr, int wc, int fr, int fq) const {
        const int row0 = u.pm * BM + wr * 64 + fr; const int colt = u.pn * BM;
        bf16_t* p0; size_t rstride, bjstride;
        if (mode == 1) { rstride = 32; p0 = O + ((size_t)(colt / 32 + wc) * ldc + row0) * 32 + 8 * fq; bjstride = (size_t)4 * ldc * 32; }
        else if (colt >= hm_lo && colt < hm_hi) { rstride = 64; p0 = HM + ((size_t)((colt - hm_lo) / 64 + (wc >> 1)) * hm_rows + row0) * 64 + (wc & 1) * 32 + 8 * fq; bjstride = (size_t)2 * hm_rows * 64; }
        else { rstride = ldc; p0 = O + (size_t)row0 * ldc + (colt - (colt >= hm_hi ? hm_hi - hm_lo : 0)) + wc * 32 + 8 * fq; bjstride = HALF; }
        if (mode == 0 && colt >= g_lo && colt < g_hi) {
            float lb[2][8];
#pragma unroll
            for (int bj = 0; bj < 2; ++bj)
#pragma unroll
                for (int e = 0; e < 8; ++e) { const int c = colt - g_lo + bj * HALF + wc * 32 + 8 * fq + e; lb[bj][e] = sigm(lbl[c] - lbl[2048 + c]); }
#pragma unroll
            for (int ai = 0; ai < 2; ++ai)
#pragma unroll
                for (int m = 0; m < 4; ++m) { bf16_t* rowp = p0 + (size_t)(ai * HALF + m * 16) * rstride;
#pragma unroll
                    for (int bj = 0; bj < 2; ++bj) { float o[8];
#pragma unroll
                        for (int e = 0; e < 8; ++e) { const float v = fminf(fmaxf(acc[ai][bj][m][e >> 2][e & 3], -30.f), 30.f); const float sg = __builtin_amdgcn_rcpf(1.0f + __expf(-v)); o[e] = __log2f(lb[bj][e] + (1.0f - lb[bj][e]) * sg); }
                        u32x4 w; w.x = cvt_pk_bf16_c(o[0], o[1]); w.y = cvt_pk_bf16_c(o[2], o[3]); w.z = cvt_pk_bf16_c(o[4], o[5]); w.w = cvt_pk_bf16_c(o[6], o[7]);
                        *(u32x4*)(rowp + bj * bjstride) = w; } }
            return;
        }
#pragma unroll
        for (int ai = 0; ai < 2; ++ai)
#pragma unroll
            for (int m = 0; m < 4; ++m) { bf16_t* rowp = p0 + (size_t)(ai * HALF + m * 16) * rstride;
#pragma unroll
                for (int bj = 0; bj < 2; ++bj) { const f32x4 v0 = acc[ai][bj][m][0], v1 = acc[ai][bj][m][1];
                    u32x4 w; w.x = cvt_pk_bf16(v0[0], v0[1]); w.y = cvt_pk_bf16(v0[2], v0[3]); w.z = cvt_pk_bf16(v1[0], v1[1]); w.w = cvt_pk_bf16(v1[2], v1[3]);
                    *(u32x4*)(rowp + bj * bjstride) = w; } }
    }
};
struct EpiMerge {
    static constexpr bool PERM = true, AFTER_DRAIN = false;
    bf16_t* Y; int ldy; const bf16_t* G; int ldg; int accum;
    __device__ __forceinline__ void operator()(const f32x4 (&acc)[2][2][4][2], const Unit& u, int wr, int wc, int fr, int fq) const {
        const int row0 = u.pm * BM + wr * 64 + fr; const int col0 = u.pn * BM + wc * 32 + 8 * fq;
#pragma unroll
        for (int ai = 0; ai < 2; ++ai)
#pragma unroll
            for (int m = 0; m < 4; ++m) { const size_t row = (size_t)(row0 + ai * HALF + m * 16);
#pragma unroll
                for (int bj = 0; bj < 2; ++bj) { const f32x4 v0 = acc[ai][bj][m][0], v1 = acc[ai][bj][m][1];
                    const u32x4 gq = *(const u32x4*)(G + row * ldg + col0 + bj * HALF);
                    u32x4 pv = (u32x4){0u, 0u, 0u, 0u}; if (accum) pv = *(const u32x4*)(Y + row * ldy + col0 + bj * HALF);
                    float o[8];
                    o[0] = sigm(bflo(gq.x)) * v0[0] + bflo(pv.x); o[1] = sigm(bfhi(gq.x)) * v0[1] + bfhi(pv.x);
                    o[2] = sigm(bflo(gq.y)) * v0[2] + bflo(pv.y); o[3] = sigm(bfhi(gq.y)) * v0[3] + bfhi(pv.y);
                    o[4] = sigm(bflo(gq.z)) * v1[0] + bflo(pv.z); o[5] = sigm(bfhi(gq.z)) * v1[1] + bfhi(pv.z);
                    o[6] = sigm(bflo(gq.w)) * v1[2] + bflo(pv.w); o[7] = sigm(bfhi(gq.w)) * v1[3] + bfhi(pv.w);
                    u32x4 w; w.x = cvt_pk_bf16(o[0], o[1]); w.y = cvt_pk_bf16(o[2], o[3]); w.z = cvt_pk_bf16(o[4], o[5]); w.w = cvt_pk_bf16(o[6], o[7]);
                    *(u32x4*)(Y + row * ldy + col0 + bj * HALF) = w; } }
    }
};
struct EpiRes {
    static constexpr bool PERM = false, AFTER_DRAIN = false;
    const float* base; float* out; const float* gate;
    __device__ __forceinline__ void operator()(const f32x4 (&acc)[2][2][4][2], const Unit& u, int wr, int wc, int fr, int fq) const {
        const int b = (u.pm * BM) >> 13; const float* gp = gate + (size_t)b * 12288;
        const int col0 = u.pn * BM + wc * 32 + 4 * fq;
        f32x4 gv[2][2];
#pragma unroll
        for (int bj = 0; bj < 2; ++bj)
#pragma unroll
            for (int n = 0; n < 2; ++n) gv[bj][n] = *(const f32x4*)(gp + col0 + bj * HALF + n * 16);
#pragma unroll
        for (int ai = 0; ai < 2; ++ai)
#pragma unroll
            for (int m = 0; m < 4; ++m) { const size_t off = (size_t)(u.pm * BM + ai * HALF + wr * 64 + m * 16 + fr) * 2048 + col0;
#pragma unroll
                for (int bj = 0; bj < 2; ++bj)
#pragma unroll
                    for (int n = 0; n < 2; ++n) { const f32x4 bs = __builtin_nontemporal_load((const f32x4*)(base + off + bj * HALF + n * 16));
                        *(f32x4*)(out + off + bj * HALF + n * 16) = bs + gv[bj][n] * acc[ai][bj][m][n]; }
                if (m & 1) asm volatile("" ::: "memory"); }
    }
};
struct EpiSwiglu {
    static constexpr bool PERM = true, AFTER_DRAIN = false;
    bf16_t* H; int ldc;
    __device__ __forceinline__ void operator()(const f32x4 (&acc)[2][2][4][2], const Unit& u, int wr, int wc, int fr, int fq) const {
        const int row0 = u.pm * BM + wr * 64 + fr; const int col0 = u.pn * HALF + wc * 32 + 8 * fq;
#pragma unroll
        for (int ai = 0; ai < 2; ++ai)
#pragma unroll
            for (int m = 0; m < 4; ++m) { bf16_t* rowp = H + (size_t)(row0 + ai * HALF + m * 16) * ldc + col0;
                float o[8];
#pragma unroll
                for (int n = 0; n < 2; ++n)
#pragma unroll
                    for (int i = 0; i < 4; ++i) { const float a = acc[ai][0][m][n][i], g = acc[ai][1][m][n][i]; o[4 * n + i] = a * sigm(a) * g; }
                u32x4 w; w.x = cvt_pk_bf16(o[0], o[1]); w.y = cvt_pk_bf16(o[2], o[3]); w.z = cvt_pk_bf16(o[4], o[5]); w.w = cvt_pk_bf16(o[6], o[7]);
                *(u32x4*)rowp = w; }
    }
};
template <class Epi, class Sched, bool ALIGN_EPI = false, bool SP2 = false>
__device__ __forceinline__ void gemm_phase(PG8_LAS unsigned char* lds, const Gemm g, const Sched& S, const Epi& E) {
    const int tid = threadIdx.x, wid = __builtin_amdgcn_readfirstlane(tid >> 6), lane = tid & 63, wr = wid >> 2, wc = wid & 3, fr = lane & 15, fq = lane >> 4;
    const int K = g.K, nt = K / BK;
    unsigned voffA[2], voffB[2];
#pragma unroll
    for (int i = 0; i < 2; ++i) { int R, C; stage_rc(tid * 16 + i * 8192, R, C); const int Rb = Epi::PERM ? ((R & ~31) + perm32(R & 31)) : R;
        voffA[i] = (unsigned)(R * K + C) * 2u; voffB[i] = (unsigned)(Rb * K + C) * 2u; }
    const size_t kstep = (size_t)(BK * 2);
    const size_t hstep = (size_t)HALF * K * 2;
    const size_t tstep = 2 * hstep;
    const unsigned ldsw = (unsigned)wid * 1024u;
    const int aoff = lds_byte(wr * 64 + fr, fq * 8), boff = lds_byte(wc * 32 + fr, fq * 8);
#define PG8_SA(b, h) (((b) * 2 + (h)) * HTB)
#define PG8_SB(b, h) ((4 + (b) * 2 + (h)) * HTB)
#define PG8_STAGE(bufoff, gbase, voff) do { _Pragma("unroll") for (int _i = 0; _i < 2; ++_i) \
        __builtin_amdgcn_global_load_lds((const unsigned*)((const char*)(gbase) + (voff)[_i]), (PG8_LAS unsigned*)(lds + (bufoff) + ldsw + _i * 8192), 16, 0, 0); } while (0)
#define PG8_LDA(dst, b, h) do { _Pragma("unroll") for (int m = 0; m < 4; ++m) _Pragma("unroll") for (int k = 0; k < 2; ++k) dst[m][k] = *(const PG8_LAS bf16x8*)(lds + PG8_SA(b, h) + aoff + m * 2048 + k * 1024); } while (0)
#define PG8_LDB(dst, b, h) do { _Pragma("unroll") for (int n = 0; n < 2; ++n) _Pragma("unroll") for (int k = 0; k < 2; ++k) dst[n][k] = *(const PG8_LAS bf16x8*)(lds + PG8_SB(b, h) + boff + n * 2048 + k * 1024); } while (0)
#define PG8_MMA(ai, bj, At, Bt) do { __builtin_amdgcn_s_setprio(1); _Pragma("unroll") for (int m = 0; m < 4; ++m) _Pragma("unroll") for (int n = 0; n < 2; ++n) _Pragma("unroll") for (int k = 0; k < 2; ++k) \
        acc[ai][bj][m][n] = __builtin_amdgcn_mfma_f32_16x16x32_bf16(Bt[n][k], At[m][k], acc[ai][bj][m][n], 0, 0, 0); __builtin_amdgcn_s_setprio(0); } while (0)
#define PG8_WAIT_V(n) asm volatile("s_waitcnt vmcnt(" #n ")" ::: "memory")
#define PG8_WAIT_L(n) asm volatile("s_waitcnt lgkmcnt(" #n ")" ::: "memory")
#define PG8_BAR __builtin_amdgcn_s_barrier()
#define PG8_SCHED __builtin_amdgcn_sched_barrier(0)
    Unit cur, nxt; int ui = 0;
    if (!S.next(0, cur)) return;
    f32x4 acc[2][2][4][2];
#pragma unroll
    for (int a = 0; a < 2; ++a)
#pragma unroll
        for (int b = 0; b < 2; ++b)
#pragma unroll
            for (int m = 0; m < 4; ++m)
#pragma unroll
                for (int n = 0; n < 2; ++n) acc[a][b][m][n] = (f32x4){0.f, 0.f, 0.f, 0.f};
    bf16x8 At[4][2], B0[2][2], B1[2][2];
    const char* cA = (const char*)g.A + (size_t)cur.pm * tstep; const char* cB = (const char*)g.Bt + (size_t)cur.pn * tstep;
    S.a_ready(cur);
    if constexpr (SP2) {
        PG8_STAGE(PG8_SB(0, 0), cB, voffB); PG8_STAGE(PG8_SB(0, 1), cB + hstep, voffB); PG8_STAGE(PG8_SA(0, 0), cA, voffA); PG8_STAGE(PG8_SA(0, 1), cA + hstep, voffA);
        if (wr == 1) PG8_BAR;
        PG8_WAIT_V(2); PG8_BAR;
        PG8_STAGE(PG8_SB(1, 0), cB + kstep, voffB); PG8_STAGE(PG8_SA(1, 0), cA + kstep, voffA); PG8_STAGE(PG8_SB(1, 1), cB + hstep + kstep, voffB);
        PG8_WAIT_V(6); PG8_BAR;
    } else {
        PG8_STAGE(PG8_SB(0, 0), cB, voffB); PG8_STAGE(PG8_SA(0, 0), cA, voffA); PG8_STAGE(PG8_SB(0, 1), cB + hstep, voffB); PG8_STAGE(PG8_SA(0, 1), cA + hstep, voffA);
        if (wr == 1) PG8_BAR;
        PG8_WAIT_V(4); PG8_BAR;
        PG8_STAGE(PG8_SB(1, 0), cB + kstep, voffB); PG8_STAGE(PG8_SA(1, 0), cA + kstep, voffA); PG8_STAGE(PG8_SB(1, 1), cB + hstep + kstep, voffB);
        PG8_WAIT_V(6); PG8_BAR;
    }
    for (;;) {
        const bool has_next = S.next(ui + 1, nxt);
        const char* nA = has_next ? (const char*)g.A + (size_t)nxt.pm * tstep : cA; const char* nB = has_next ? (const char*)g.Bt + (size_t)nxt.pn * tstep : cB;
        for (int t = 0; t < nt; t += 2) {
            const bool last = (t == nt - 2);
            const char* a1 = cA + (size_t)(t + 1) * kstep;
            const char* a2 = last ? nA : cA + (size_t)(t + 2) * kstep; const char* b2 = last ? nB : cB + (size_t)(t + 2) * kstep;
            const char* a3 = a2 + kstep; const char* b3 = b2 + kstep;
            if (last && has_next) S.a_ready(nxt);
            if constexpr (SP2) {
            PG8_LDB(B0, 0, 0); PG8_LDB(B1, 0, 1); PG8_SCHED; PG8_LDA(At, 0, 0); PG8_STAGE(PG8_SA(1, 1), a1 + hstep, voffA);
            PG8_WAIT_V(8); PG8_WAIT_L(0); PG8_BAR; PG8_MMA(0, 0, At, B0); PG8_MMA(0, 1, At, B1); PG8_BAR; PG8_SCHED;
            PG8_LDA(At, 0, 1); PG8_STAGE(PG8_SB(0, 0), b2, voffB); PG8_STAGE(PG8_SB(0, 1), b2 + hstep, voffB); PG8_STAGE(PG8_SA(0, 0), a2, voffA);
            PG8_WAIT_V(8); PG8_WAIT_L(0); PG8_BAR; PG8_MMA(1, 0, At, B0); PG8_MMA(1, 1, At, B1); PG8_BAR; PG8_SCHED;
            PG8_LDB(B0, 1, 0); PG8_LDB(B1, 1, 1); PG8_SCHED; PG8_LDA(At, 1, 0); PG8_STAGE(PG8_SA(0, 1), a2 + hstep, voffA);
            PG8_WAIT_V(8); PG8_WAIT_L(0); PG8_BAR; PG8_MMA(0, 0, At, B0); PG8_MMA(0, 1, At, B1); PG8_BAR; PG8_SCHED;
            PG8_LDA(At, 1, 1); PG8_STAGE(PG8_SB(1, 0), b3, voffB); PG8_STAGE(PG8_SB(1, 1), b3 + hstep, voffB); PG8_STAGE(PG8_SA(1, 0), a3, voffA);
            PG8_WAIT_V(8); PG8_WAIT_L(0); PG8_BAR; PG8_MMA(1, 0, At, B0); PG8_MMA(1, 1, At, B1); PG8_BAR; PG8_SCHED;
            } else {
            PG8_LDB(B0, 0, 0); PG8_SCHED; PG8_LDA(At, 0, 0); PG8_STAGE(PG8_SA(1, 1), a1 + hstep, voffA);
            PG8_WAIT_L(8); PG8_BAR; PG8_WAIT_L(0); PG8_MMA(0, 0, At, B0); PG8_BAR; PG8_SCHED;
            PG8_LDB(B1, 0, 1); PG8_STAGE(PG8_SB(0, 0), b2, voffB);
            PG8_BAR; PG8_WAIT_L(0); PG8_MMA(0, 1, At, B1); PG8_BAR;
            PG8_LDA(At, 0, 1); PG8_STAGE(PG8_SA(0, 0), a2, voffA);
            PG8_BAR; PG8_WAIT_L(0); PG8_MMA(1, 0, At, B0); PG8_BAR; PG8_SCHED;
            PG8_STAGE(PG8_SB(0, 1), b2 + hstep, voffB);
            PG8_WAIT_V(6); PG8_BAR; PG8_MMA(1, 1, At, B1); PG8_BAR;
            PG8_LDB(B0, 1, 0); PG8_SCHED; PG8_LDA(At, 1, 0); PG8_STAGE(PG8_SA(0, 1), a2 + hstep, voffA);
            PG8_WAIT_L(8); PG8_BAR; PG8_WAIT_L(0); PG8_MMA(0, 0, At, B0); PG8_BAR; PG8_SCHED;
            PG8_LDB(B1, 1, 1); PG8_STAGE(PG8_SB(1, 0), b3, voffB);
            PG8_BAR; PG8_WAIT_L(0); PG8_MMA(0, 1, At, B1); PG8_BAR;
            PG8_LDA(At, 1, 1); PG8_STAGE(PG8_SA(1, 0), a3, voffA);
            PG8_BAR; PG8_WAIT_L(0); PG8_MMA(1, 0, At, B0); PG8_BAR; PG8_SCHED;
            PG8_STAGE(PG8_SB(1, 1), b3 + hstep, voffB);
            PG8_WAIT_V(6); PG8_BAR; PG8_MMA(1, 1, At, B1); PG8_BAR;
            }
        }
        if constexpr (ALIGN_EPI) { if (wr == 0) PG8_BAR; }
        if constexpr (!Epi::AFTER_DRAIN) { E(acc, cur, wr, wc, fr, fq); S.done(cur); }
        if (!has_next) break;
#pragma unroll
        for (int a = 0; a < 2; ++a)
#pragma unroll
            for (int b = 0; b < 2; ++b)
#pragma unroll
                for (int m = 0; m < 4; ++m)
#pragma unroll
                    for (int n = 0; n < 2; ++n) acc[a][b][m][n] = (f32x4){0.f, 0.f, 0.f, 0.f};
        cur = nxt; cA = nA; cB = nB; ++ui;
        if constexpr (ALIGN_EPI) { if (wr == 1) PG8_BAR; }
    }
    PG8_WAIT_V(0);
    if constexpr (!ALIGN_EPI) { if (wr == 0) PG8_BAR; }
    PG8_BAR;
    if constexpr (Epi::AFTER_DRAIN) { E.fused(acc, cur, wr, wc, fr, fq, lds, wid, lane); S.done(cur); }
#undef PG8_SA
#undef PG8_SB
#undef PG8_STAGE
#undef PG8_LDA
#undef PG8_LDB
#undef PG8_MMA
#undef PG8_WAIT_V
#undef PG8_WAIT_L
#undef PG8_BAR
#undef PG8_SCHED
}
}
#define LAS __attribute__((address_space(3)))
#define DI __device__ __forceinline__
typedef unsigned short bf16;
typedef short bf16x8 __attribute__((ext_vector_type(8)));
typedef short s16x4 __attribute__((ext_vector_type(4)));
typedef float f32x4 __attribute__((ext_vector_type(4)));
typedef float f32x16 __attribute__((ext_vector_type(16)));
typedef unsigned u32x4 __attribute__((ext_vector_type(4)));
typedef unsigned u32x2 __attribute__((ext_vector_type(2)));
typedef float f32x2_t __attribute__((ext_vector_type(2)));
typedef __bf16 bf16x2_t __attribute__((ext_vector_type(2)));
DI unsigned pk2(float lo, float hi) { f32x2_t v = {lo, hi}; bf16x2_t b = __builtin_convertvector(v, bf16x2_t); return __builtin_bit_cast(unsigned, b); }
DI unsigned short f2bf(float x) { return (unsigned short)(pk2(x, 0.f) & 0xffffu); }
DI float bf2f(unsigned short u) { return __uint_as_float(((unsigned)u) << 16); }
using pg8::sigm;
DI int crow(int r, int hi) { return (r & 3) + 8 * (r >> 2) + 4 * hi; }
#define MFMA32(a, b, c) __builtin_amdgcn_mfma_f32_32x32x16_bf16((a), (b), (c), 0, 0, 0)
DI bf16x8 pack8(const f32x16& x, int s) {
    u32x4 p; p.x = pk2(x[8 * s], x[8 * s + 1]); p.y = pk2(x[8 * s + 2], x[8 * s + 3]); p.z = pk2(x[8 * s + 4], x[8 * s + 5]); p.w = pk2(x[8 * s + 6], x[8 * s + 7]);
    return __builtin_bit_cast(bf16x8, p);
}
DI bf16x8 join44(s16x4 a, s16x4 b) { return (bf16x8){a[0], a[1], a[2], a[3], b[0], b[1], b[2], b[3]}; }
DI float wave_sum(float v) {
#pragma unroll
    for (int o = 1; o < 64; o <<= 1) v += __shfl_xor(v, o);
    return v;
}

constexpr int NB = 4, SEQ = 8192, DM = 2048, CTX = 256, M = NB * SEQ, MC = NB * CTX;
constexpr int NIN = 12288, FFH = 5632, NMOD = 12288;
constexpr int U1W = 8192;
constexpr int C_HQ = 0, C_HFF = 1024, C_HOG = 3072, C_GA = 4096, C_GB = 6144;
constexpr int W_NOW = 6144;
constexpr int UC1W = 2048;
constexpr float EPS = 1e-6f;
constexpr float LOG2E = 1.4426950408889634f;
constexpr size_t MiB = 1u << 20;
constexpr size_t WS_MOD = 0, WS_PART = 1 * MiB, WS_WIN = 16 * MiB, WS_WPA = 64 * MiB, WS_WPB = 68 * MiB, WS_WOUT = 72 * MiB, WS_WF1 = 80 * MiB, WS_WF2 = 124 * MiB;
constexpr size_t WS_KHC = 146 * MiB, WS_UC1 = 148 * MiB, WS_VTC = 152 * MiB, WS_HC = 156 * MiB, WS_QKH = 160 * MiB, WS_U1 = 288 * MiB, WS_VT = 800 * MiB, WS_OB = 928 * MiB, WS_END = 992 * MiB;
constexpr size_t WS_YM = WS_VT, WS_H2 = WS_QKH, WS_HID = WS_U1;
constexpr size_t DO_H = 0, DO_ONA = 128 * MiB, DO_OF = 192 * MiB, DO_OHG = 0;
constexpr int LDS_BYTES = 147456;
constexpr size_t WS_BAR = 768 * 1024, BAR_BYTES = 16384;
constexpr int LDS_MISC = 131072;
constexpr int NPH = 12;
#ifndef MK_SPLIT
#define MK_SPLIT 0
#endif
constexpr bool USE_XCD_BAR = (MK_SPLIT == 0);
constexpr int GU_FILL = 176, GU_SPLIT2 = GU_FILL + 8 * 192;
constexpr int GU_SPLIT = 1728;

__device__ const int kInRowMap[12] = {1024, 2048, 10240, 0, 3072, 4096, 11264, 5120, 6144, 7168, 8192, 9216};

struct Args { const float* in[18]; float* out; unsigned char* ws; int ph_lo, ph_hi; };

DI void transpose_item(const float* W, int K, int N, bf16* WT, int k0, int n0, int drow0, LAS float* scr, int lane) {
#pragma unroll 8
    for (int i = 0; i < 32; ++i) { const int kk = 2 * i + (lane >> 5); scr[kk * 33 + (lane & 31)] = __builtin_nontemporal_load(W + (size_t)(k0 + kk) * N + n0 + (lane & 31)); }
    asm volatile("s_waitcnt lgkmcnt(0)" ::: "memory");
    const int c = lane & 7;
#pragma unroll
    for (int j = 0; j < 4; ++j) { const int n = (lane >> 3) + 8 * j; const LAS float* s = scr + (8 * c) * 33 + n;
        u32x4 o; o.x = pk2(s[0 * 33], s[1 * 33]); o.y = pk2(s[2 * 33], s[3 * 33]); o.z = pk2(s[4 * 33], s[5 * 33]); o.w = pk2(s[6 * 33], s[7 * 33]);
        *(u32x4*)(WT + (size_t)(drow0 + n) * K + k0 + 8 * c) = o; }
    asm volatile("s_waitcnt lgkmcnt(0)" ::: "memory");
}

DI void norm_row(const float* xrow, const float* g, const float* sc, const float* sh, bf16* obf, float* of32, int lane) {
    const f32x4* xr = (const f32x4*)xrow + lane;
    f32x4 v[8]; float s = 0.f;
#pragma unroll
    for (int j = 0; j < 8; ++j) { v[j] = xr[64 * j]; s += (v[j].x * v[j].x + v[j].y * v[j].y) + (v[j].z * v[j].z + v[j].w * v[j].w); }
    const float rstd = 1.0f / sqrtf(wave_sum(s) * (1.0f / DM) + EPS);
#pragma unroll
    for (int j = 0; j < 8; ++j) {
        const int c4 = lane + 64 * j;
        f32x4 y = v[j] * rstd * ((const f32x4*)g)[c4];
        if (sc) y = y * (((const f32x4*)sc)[c4] + 1.0f) + ((const f32x4*)sh)[c4];
        if (obf) { u32x2 o; o.x = pk2(y.x, y.y); o.y = pk2(y.z, y.w); ((u32x2*)obf)[c4] = o; }
        else ((f32x4*)of32)[c4] = y;
    }
}

template <bool NT_LD, bool NT_ST> DI void norm_row2(const float* xrow0, const float* xrow1, const float* g, const float* sc, const float* sh, bf16* obf0, bf16* obf1, float* of0, float* of1, int lane) {
    const f32x4* xr0 = (const f32x4*)xrow0 + lane; const f32x4* xr1 = (const f32x4*)xrow1 + lane;
    f32x4 v0[8], v1[8]; float s0 = 0.f, s1 = 0.f;
#pragma unroll
    for (int j = 0; j < 8; ++j) { if (NT_LD) { v0[j] = __builtin_nontemporal_load(xr0 + 64 * j); v1[j] = __builtin_nontemporal_load(xr1 + 64 * j); } else { v0[j] = xr0[64 * j]; v1[j] = xr1[64 * j]; } }
#pragma unroll
    for (int j = 0; j < 8; ++j) { s0 += (v0[j].x * v0[j].x + v0[j].y * v0[j].y) + (v0[j].z * v0[j].z + v0[j].w * v0[j].w); s1 += (v1[j].x * v1[j].x + v1[j].y * v1[j].y) + (v1[j].z * v1[j].z + v1[j].w * v1[j].w); }
#pragma unroll
    for (int o = 1; o < 64; o <<= 1) { s0 += __shfl_xor(s0, o); s1 += __shfl_xor(s1, o); }
    const float r0 = 1.0f / sqrtf(s0 * (1.0f / DM) + EPS), r1 = 1.0f / sqrtf(s1 * (1.0f / DM) + EPS);
#pragma unroll
    for (int j = 0; j < 8; ++j) {
        const int c4 = lane + 64 * j;
        const f32x4 gg = ((const f32x4*)g)[c4];
        f32x4 y0 = v0[j] * r0 * gg, y1 = v1[j] * r1 * gg;
        if (sc) { const f32x4 a = ((const f32x4*)sc)[c4] + 1.0f, bsh = ((const f32x4*)sh)[c4]; y0 = y0 * a + bsh; y1 = y1 * a + bsh; }
        if (obf0) { u32x2 o0; o0.x = pk2(y0.x, y0.y); o0.y = pk2(y0.z, y0.w); ((u32x2*)obf0)[c4] = o0; u32x2 o1; o1.x = pk2(y1.x, y1.y); o1.y = pk2(y1.z, y1.w); ((u32x2*)obf1)[c4] = o1; }
        else if (NT_ST) { __builtin_nontemporal_store(y0, (f32x4*)of0 + c4); __builtin_nontemporal_store(y1, (f32x4*)of1 + c4); }
        else { ((f32x4*)of0)[c4] = y0; ((f32x4*)of1)[c4] = y1; }
    }
}

DI float max3f(float a, float b, float c) { float r; asm("v_max3_f32 %0, %1, %2, %3" : "=v"(r) : "v"(a), "v"(b), "v"(c)); return r; }
constexpr float NA_RESCALE_THR = 6.0f;
constexpr int RPB_OFF = 64;
constexpr int RPB_NINF = RPB_OFF + 16 * 15 * 31 + 128;
constexpr int RPB_FLOATS = RPB_NINF + 64;
DI void na_load_k(int blk, int b, int rs0, int kc0, int h, int l32, int hi, const bf16* QKH, const bf16* KHC, bf16x8 (&kf)[4]) {
    const bf16* kp;
    if (blk < 8) { const int tok = b * CTX + 32 * blk; kp = KHC + ((size_t)h * MC + tok + l32) * 64 + 8 * hi; }
    else { const int tok = b * SEQ + (rs0 + blk - 8) * 64 + kc0; kp = QKH + ((size_t)(16 + h) * M + tok + l32) * 64 + 8 * hi; }
#pragma unroll
    for (int s = 0; s < 4; ++s) kf[s] = *(const bf16x8*)(kp + 16 * s);
}
DI void na_load_v(int blk, int b, int rs0, int kc0, int h, int l32, int hi, const bf16* VT, const bf16* VTC, bf16x8 (&vf)[2][2]) {
    const bf16* vb; int t0;
    if (blk < 8) { vb = VTC; t0 = b * CTX + 32 * blk + 4 * hi; }
    else { vb = VT; t0 = b * SEQ + (rs0 + blk - 8) * 64 + kc0 + 4 * hi; }
    const bf16* vp = vb + (size_t)(h * 64 + l32) * 32;
#pragma unroll
    for (int d = 0; d < 2; ++d)
#pragma unroll
        for (int s = 0; s < 2; ++s) { const int ta = t0 + 16 * s, tb = ta + 8;
            vf[d][s] = join44(*(const s16x4*)(vp + (size_t)(ta >> 5) * 65536 + (size_t)(32 * d) * 32 + (ta & 31)), *(const s16x4*)(vp + (size_t)(tb >> 5) * 65536 + (size_t)(32 * d) * 32 + (tb & 31))); }
}
struct NaState { f32x16 o0, o1; float mrun, lrun; };
template <bool BAND> DI void na_block(NaState& st_, const bf16x8 (&kf)[4], const bf16x8 (&vf)[2][2], const bf16x8 (&qf)[4], const LAS float* rp, const LAS float* madd) {
    const float C1 = 0.125f * LOG2E;
    f32x16 st;
#pragma unroll
    for (int i = 0; i < 16; ++i) st[i] = 0.f;
#pragma unroll
    for (int s = 0; s < 4; ++s) st = MFMA32(kf[s], qf[s], st);
    if (BAND) {
#pragma unroll
        for (int i = 0; i < 16; ++i) { const float bb = rp[(i & 3) + 8 * (i >> 2)] + madd[i * 64]; st[i] = __builtin_fmaf(st[i], C1, bb); }
    } else {
#pragma unroll
        for (int i = 0; i < 16; ++i) st[i] *= C1;
    }
    float mx = max3f(st[0], st[1], st[2]);
#pragma unroll
    for (int i = 3; i < 15; i += 2) mx = max3f(mx, st[i], st[i + 1]);
    mx = fmaxf(mx, st[15]);
    { const auto rr = __builtin_amdgcn_permlane32_swap(__float_as_uint(mx), __float_as_uint(mx), false, false); mx = fmaxf(__uint_as_float(rr[0]), __uint_as_float(rr[1])); }
    if (__any(mx > st_.mrun + NA_RESCALE_THR)) {
        const float mnew = fmaxf(st_.mrun, mx);
        const float alpha = __builtin_amdgcn_exp2f(st_.mrun - mnew);
        st_.mrun = mnew; st_.lrun *= alpha;
#pragma unroll
        for (int i = 0; i < 16; ++i) { st_.o0[i] *= alpha; st_.o1[i] *= alpha; }
    }
    float ps = 0.f; const float mm = st_.mrun;
#pragma unroll
    for (int i = 0; i < 16; ++i) { st[i] = __builtin_amdgcn_exp2f(st[i] - mm); ps += st[i]; }
    st_.lrun += ps;
    const bf16x8 p0 = pack8(st, 0), p1 = pack8(st, 1);
    st_.o0 = MFMA32(vf[0][0], p0, st_.o0); st_.o0 = MFMA32(vf[0][1], p1, st_.o0);
    st_.o1 = MFMA32(vf[1][0], p0, st_.o1); st_.o1 = MFMA32(vf[1][1], p1, st_.o1);
}
DI void na_task(int task, const bf16* QKH, const bf16* KHC, const bf16* VT, const bf16* VTC, bf16* ONA, const LAS float* rpb, LAS float* mtab, int lane) {
    const int cq = task & 3, h = (task >> 2) & 15, rpair = (task >> 6) & 63, b = task >> 12;
    const int l32 = lane & 31, hi = lane >> 5;
    const int r = 2 * rpair + (l32 >> 4), qc = 16 * cq + (l32 & 15);
    const int rs = min(max(r - 4, 0), 120);
    const int rs0 = min(max(2 * rpair - 4, 0), 120), rs1 = min(max(2 * rpair - 3, 0), 120);
    const int nb = 8 + (rs1 + 8 - rs0);
    const int kc0 = (cq == 0) ? 0 : (cq == 1) ? 8 : (cq == 2) ? 24 : 32;
    const int cs = min(max(qc - 8, 0), 48);
    const bf16* qp = QKH + ((size_t)h * M + b * SEQ + r * 64 + qc) * 64 + 8 * hi;
    bf16x8 qf[4];
#pragma unroll
    for (int s = 0; s < 4; ++s) qf[s] = *(const bf16x8*)(qp + 16 * s);
    LAS float* madd = mtab + lane;
#pragma unroll
    for (int i = 0; i < 16; ++i) { const int kc = kc0 + crow(i, hi); madd[i * 64] = (kc >= cs && kc < cs + 16) ? 0.f : -INFINITY; }
    NaState S;
#pragma unroll
    for (int i = 0; i < 16; ++i) { S.o0[i] = 0.f; S.o1[i] = 0.f; }
    S.mrun = -INFINITY; S.lrun = 0.f;
    const LAS float* rpq = rpb + RPB_OFF + (h * 15 + 7 - r) * 31 + (15 - qc + kc0 + 4 * hi);
    const LAS float* rpn = rpb + RPB_NINF + 4 * hi;
    bf16x8 kfn[4], vf[2][2];
    na_load_k(0, b, rs0, kc0, h, l32, hi, QKH, KHC, kfn);
    for (int blk = 0; blk < nb; ++blk) {
        bf16x8 kf[4];
#pragma unroll
        for (int s = 0; s < 4; ++s) kf[s] = kfn[s];
        na_load_v(blk, b, rs0, kc0, h, l32, hi, VT, VTC, vf);
        if (blk + 1 < nb) na_load_k(blk + 1, b, rs0, kc0, h, l32, hi, QKH, KHC, kfn);
        if (blk < 8) na_block<false>(S, kf, vf, qf, rpq, madd);
        else { const int krow = rs0 + blk - 8; const bool rv = (krow >= rs) && (krow < rs + 8);
            na_block<true>(S, kf, vf, qf, rv ? rpq + krow * 31 : rpn, madd); }
    }
    float lrun = S.lrun; lrun += __shfl_xor(lrun, 32);
    const float inv = 1.0f / lrun;
    bf16* op = ONA + (size_t)(b * SEQ + r * 64 + qc) * 1024 + h * 64 + 4 * hi;
#pragma unroll
    for (int g = 0; g < 4; ++g) {
        u32x2 w0; w0.x = pk2(S.o0[4 * g] * inv, S.o0[4 * g + 1] * inv); w0.y = pk2(S.o0[4 * g + 2] * inv, S.o0[4 * g + 3] * inv); *(u32x2*)(op + 8 * g) = w0;
        u32x2 w1; w1.x = pk2(S.o1[4 * g] * inv, S.o1[4 * g + 1] * inv); w1.y = pk2(S.o1[4 * g + 2] * inv, S.o1[4 * g + 3] * inv); *(u32x2*)(op + 32 + 8 * g) = w1;
    }
}

constexpr int HP = 136;
constexpr int HKP = 40;
constexpr int H_AT = 0, H_QP = 32 * HP * 2, H_KT = 2 * 32 * HP * 2, H_KTT = 3 * 32 * HP * 2, H_DV = H_KTT + 128 * HKP * 2, H_BUF = H_DV + 512;
constexpr int H_GT = 2 * H_BUF;
struct HgGate { int dir, tqs, kp; const bf16* x1u; const bf16* x0u; const bf16* q1u; LAS float* GT; LAS unsigned char* lds; };
#define HG_T0D(g, dir) (((g) >= 8) ? ((dir) ? SEQ - 32 - 32 * ((g) - 8) : 32 * ((g) - 8)) : ((dir) ? CTX - 32 - 32 * (g) : 32 * (g)))
DI void hg_load_gate(const HgGate& c, int g, unsigned (&xo_)[8], unsigned (&q_)[8]) {
    const int sg_ = g >= 8; const int r0_ = HG_T0D(g, c.dir) + 8 * c.tqs; const bf16* xb_ = sg_ ? c.x1u : c.x0u; const size_t xp_ = sg_ ? U1W : UC1W;
#pragma unroll
    for (int i = 0; i < 8; ++i) { xo_[i] = ((const unsigned*)(xb_ + (size_t)(r0_ + i) * xp_))[c.kp]; q_[i] = ((const unsigned*)(c.q1u + (size_t)(r0_ + i) * U1W))[c.kp]; }
}
DI void hg_sums(const HgGate& c, int par, const unsigned (&xo_)[8]) {
    float a0_ = 0.f, a1_ = 0.f;
#pragma unroll
    for (int i = 0; i < 8; ++i) { a0_ += pg8::bflo(xo_[i]); a1_ += pg8::bfhi(xo_[i]); }
    *(LAS f32x2_t*)(c.GT + ((par & 1) * 4 + c.tqs) * 128 + 2 * c.kp) = (f32x2_t){a0_, a1_};
}
template <int NC> DI void hg_gate_tick(const HgGate& c, int t, const unsigned (&xo_c)[8], const unsigned (&q_c)[8], const unsigned (&xo_n)[8], unsigned (&xo_p)[8], unsigned (&q_p)[8]) {
    const int dir = c.dir, tqs = c.tqs, kp = c.kp;
    hg_load_gate(c, (t + 2 < NC) ? t + 2 : NC - 1, xo_p, q_p);
    hg_sums(c, t + 1, xo_n);
    {
        const int seg = t >= 8;
        LAS unsigned char* buf = c.lds + (t & 1) * H_BUF;
        const LAS float* gt = c.GT + (t & 1) * 512 + 2 * kp;
        const f32x2_t g0 = *(const LAS f32x2_t*)gt, g1 = *(const LAS f32x2_t*)(gt + 128), g2 = *(const LAS f32x2_t*)(gt + 256), g3 = *(const LAS f32x2_t*)(gt + 384);
        const float tot0 = (g0.x + g1.x) + (g2.x + g3.x), tot1 = (g0.y + g1.y) + (g2.y + g3.y);
        float of0, of1;
        if (!dir) { of0 = (tqs > 0 ? g0.x : 0.f) + (tqs > 1 ? g1.x : 0.f) + (tqs > 2 ? g2.x : 0.f); of1 = (tqs > 0 ? g0.y : 0.f) + (tqs > 1 ? g1.y : 0.f) + (tqs > 2 ? g2.y : 0.f); }
        else { of0 = (tqs < 3 ? g3.x : 0.f) + (tqs < 2 ? g2.x : 0.f) + (tqs < 1 ? g1.x : 0.f); of1 = (tqs < 3 ? g3.y : 0.f) + (tqs < 2 ? g2.y : 0.f) + (tqs < 1 ? g1.y : 0.f); }
        float c0[8], c1[8];
        if (!dir) { float a0 = of0, a1 = of1;
#pragma unroll
            for (int i = 0; i < 8; ++i) { a0 += pg8::bflo(xo_c[i]); a1 += pg8::bfhi(xo_c[i]); c0[i] = a0; c1[i] = a1; } }
        else { float a0 = of0, a1 = of1;
#pragma unroll
            for (int i = 7; i >= 0; --i) { a0 += pg8::bflo(xo_c[i]); a1 += pg8::bfhi(xo_c[i]); c0[i] = a0; c1[i] = a1; } }
        LAS unsigned* Qp = (LAS unsigned*)(buf + H_QP); LAS unsigned* Kt = (LAS unsigned*)(buf + H_KT); LAS bf16* KtT = (LAS bf16*)(buf + H_KTT); LAS float* dv = (LAS float*)(buf + H_DV);
        const float d0 = __builtin_amdgcn_exp2f(tot0), d1 = __builtin_amdgcn_exp2f(tot1);
        float k0v[8], k1v[8], r0[8], r1[8];
        const float ri0 = __builtin_amdgcn_rcpf(__builtin_amdgcn_exp2f(fmaxf(of0, -100.f))), ri1 = __builtin_amdgcn_rcpf(__builtin_amdgcn_exp2f(fmaxf(of1, -100.f)));
#pragma unroll
        for (int i = 0; i < 8; ++i) { const int j = 8 * tqs + i;
            const float e0 = __builtin_amdgcn_exp2f(fmaxf(c0[i], -100.f)), e1 = __builtin_amdgcn_exp2f(fmaxf(c1[i], -100.f));
            r0[i] = __builtin_amdgcn_rcpf(e0); r1[i] = __builtin_amdgcn_rcpf(e1);
            if (seg) Qp[j * (HP / 2) + kp] = pk2(pg8::bflo(q_c[i]) * e0, pg8::bfhi(q_c[i]) * e1); }
#pragma unroll
        for (int i = 0; i < 8; ++i) { const int j = 8 * tqs + i;
            const float p0 = dir ? (i < 7 ? r0[i < 7 ? i + 1 : 7] : ri0) : (i > 0 ? r0[i > 0 ? i - 1 : 0] : ri0), p1 = dir ? (i < 7 ? r1[i < 7 ? i + 1 : 7] : ri1) : (i > 0 ? r1[i > 0 ? i - 1 : 0] : ri1);
            k0v[i] = r0[i] - p0; k1v[i] = r1[i] - p1;
            Kt[j * (HP / 2) + kp] = pk2(k0v[i], k1v[i]); }
        { u32x4 w; w.x = pk2(k0v[0], k0v[1]); w.y = pk2(k0v[2], k0v[3]); w.z = pk2(k0v[4], k0v[5]); w.w = pk2(k0v[6], k0v[7]); *(LAS u32x4*)(KtT + (2 * kp) * HKP + 8 * tqs) = w; }
        { u32x4 w; w.x = pk2(k1v[0], k1v[1]); w.y = pk2(k1v[2], k1v[3]); w.z = pk2(k1v[4], k1v[5]); w.w = pk2(k1v[6], k1v[7]); *(LAS u32x4*)(KtT + (2 * kp + 1) * HKP + 8 * tqs) = w; }
        if (tqs == 0) { dv[2 * kp] = d0; dv[2 * kp + 1] = d1; }
    }
    asm volatile("s_waitcnt lgkmcnt(0)\n\ts_barrier" ::: "memory");
}
DI void hgrn_item(int item, const float* lbl, const bf16* U1, const bf16* UC1, const bf16* VT, const bf16* VTC, bf16* OF, bf16* OB, LAS unsigned char* lds) {
    const int b = item >> 4, h = (item >> 1) & 7, dir = item & 1;
    const int tid = threadIdx.x, lane = tid & 63, wave = __builtin_amdgcn_readfirstlane(tid >> 6), l32 = lane & 31, hi = lane >> 5;
    const bool gate_role = wave >= 4;
    const int kp = tid & 63, tq = (tid >> 6) & 3;
    bf16* OD = dir ? OB : OF;
    constexpr int NC = CTX / 32 + SEQ / 32;
    const bf16* x1 = U1 + (size_t)(b * SEQ) * U1W + C_HFF + dir * 1024 + h * 128 + 2 * kp;
    const bf16* x0 = UC1 + (size_t)(b * CTX) * UC1W + dir * 1024 + h * 128 + 2 * kp;
    const bf16* q1 = U1 + (size_t)(b * SEQ) * U1W + C_HQ + h * 128 + 2 * kp;
    const bf16* v1 = VT + (size_t)((b * SEQ) >> 5) * 65536 + (size_t)(1024 + h * 128 + 32 * (wave & 3) + l32) * 32 + 4 * hi;
    const bf16* v0 = VTC + (size_t)((b * CTX) >> 5) * 65536 + (size_t)(1024 + h * 128 + 32 * (wave & 3) + l32) * 32 + 4 * hi;
    f32x16 S[4];
#pragma unroll
    for (int a = 0; a < 4; ++a)
#pragma unroll
        for (int i = 0; i < 16; ++i) S[a][i] = 0.f;
    unsigned xo_c[8], q_c[8], xo_n[8], q_n[8], xo_p[8], q_p[8]; s16x4 vn[4];
    const int tqs = wave & 3;
    const bf16* x1u = U1 + (size_t)(b * SEQ) * U1W + C_HFF + dir * 1024 + h * 128;
    const bf16* x0u = UC1 + (size_t)(b * CTX) * UC1W + dir * 1024 + h * 128;
    const bf16* q1u = U1 + (size_t)(b * SEQ) * U1W + C_HQ + h * 128;
    LAS float* GT = (LAS float*)(lds + H_GT);
#define HG_T0(g) (((g) >= 8) ? (dir ? SEQ - 32 - 32 * ((g) - 8) : 32 * ((g) - 8)) : (dir ? CTX - 32 - 32 * (g) : 32 * (g)))
#define HG_LOAD_GATE(g, xo_, q_) do { const int sg_ = (g) >= 8; const int r0_ = HG_T0(g) + 8 * tqs; const bf16* xb_ = sg_ ? x1u : x0u; const size_t xp_ = sg_ ? U1W : UC1W; \
        _Pragma("unroll") for (int i = 0; i < 8; ++i) { xo_[i] = ((const unsigned*)(xb_ + (size_t)(r0_ + i) * xp_))[kp]; q_[i] = sg_ ? ((const unsigned*)(q1u + (size_t)(r0_ + i) * U1W))[kp] : 0u; } } while (0)
#define HG_SUMS(g, xo_) do { float a0_ = 0.f, a1_ = 0.f; _Pragma("unroll") for (int i = 0; i < 8; ++i) { a0_ += pg8::bflo(xo_[i]); a1_ += pg8::bfhi(xo_[i]); } \
        *(LAS f32x2_t*)(GT + (((g) & 1) * 4 + tqs) * 128 + 2 * kp) = (f32x2_t){a0_, a1_}; } while (0)
#define HG_LOAD_V(g) do { const int t0_ = HG_T0(g); const bf16* vb_ = ((g) >= 8) ? v1 : v0; \
        _Pragma("unroll") for (int s = 0; s < 4; ++s) vn[s] = *(const s16x4*)(vb_ + (size_t)(t0_ >> 5) * 65536 + 8 * s); } while (0)
    if (gate_role) {
        const HgGate gc{dir, tqs, kp, x1u, x0u, q1u, GT, lds};
        hg_load_gate(gc, 0, xo_c, q_c); hg_load_gate(gc, 1, xo_n, q_n);
        hg_sums(gc, 0, xo_c);
        asm volatile("s_waitcnt lgkmcnt(0)\n\ts_barrier" ::: "memory");
        static_assert(NC % 3 == 0, "three ticks per trip");
        for (int t = 0; t < NC; t += 3) {
            hg_gate_tick<NC>(gc, t, xo_c, q_c, xo_n, xo_p, q_p);
            hg_gate_tick<NC>(gc, t + 1, xo_n, q_n, xo_p, xo_c, q_c);
            hg_gate_tick<NC>(gc, t + 2, xo_p, q_p, xo_c, xo_n, q_n);
        }
        asm volatile("s_waitcnt lgkmcnt(0)\n\ts_barrier" ::: "memory");
    } else {
        HG_LOAD_V(0);
        unsigned ob[16]; int ob_t0 = 0; bool have_ob = false;
#pragma unroll
        for (int i = 0; i < 16; ++i) ob[i] = 0u;
        asm volatile("s_waitcnt lgkmcnt(0)\n\ts_barrier" ::: "memory");
        for (int t = 0; t <= NC; ++t) {
            if (t >= 1) {
                const int g = t - 1, seg = g >= 8, t0 = HG_T0(g);
                LAS unsigned char* buf = lds + (g & 1) * H_BUF;
                LAS bf16* At = (LAS bf16*)(buf + H_AT); LAS bf16* Qp = (LAS bf16*)(buf + H_QP); LAS bf16* Kt = (LAS bf16*)(buf + H_KT); LAS bf16* KtT = (LAS bf16*)(buf + H_KTT); LAS float* dv = (LAS float*)(buf + H_DV);
                bf16x8 vf0 = join44(vn[0], vn[1]), vf1 = join44(vn[2], vn[3]);
                asm volatile("" : "+v"(vf0), "+v"(vf1));
                if (t < NC) HG_LOAD_V(t);
                if (have_ob) {
                    bf16* op = OD + (size_t)(b * SEQ + ob_t0) * 1024 + h * 128 + 32 * wave + l32;
#pragma unroll
                    for (int i = 0; i < 16; ++i) op[(size_t)crow(i, hi) * 1024] = (bf16)ob[i];
                    have_ob = false;
                }
                const LAS bf16* kp_ = Kt + l32 * HP + 8 * hi; const LAS bf16* ap_ = Qp + l32 * HP + 8 * hi;     const LAS bf16* qp_ = Qp + l32 * HP + 4 * hi; const LAS bf16* tp_ = KtT + l32 * HKP + 4 * hi;
#define HG_RD(s8, kf_, af_, qf_, tf_) do { tf_ = join44(*(const LAS s16x4*)(tp_ + 32 * ((s8) >> 1) * HKP + 16 * ((s8) & 1)), *(const LAS s16x4*)(tp_ + 32 * ((s8) >> 1) * HKP + 16 * ((s8) & 1) + 8)); \
        if (seg) { kf_ = *(const LAS bf16x8*)(kp_ + 16 * (s8)); af_ = *(const LAS bf16x8*)(ap_ + 16 * (s8)); qf_ = join44(*(const LAS s16x4*)(qp_ + 16 * (s8)), *(const LAS s16x4*)(qp_ + 16 * (s8) + 8)); } } while (0)
                f32x16 pT, o;
#pragma unroll
                for (int i = 0; i < 16; ++i) { pT[i] = 0.f; o[i] = 0.f; }
                bf16x8 kA = vf0, aA = vf0, qA = vf0, tA = vf0, kB = vf0, aB = vf0, qB = vf0, tB = vf0;
                HG_RD(0, kA, aA, qA, tA);
#pragma unroll
                for (int kt = 0; kt < 4; ++kt) {
                    bf16x8 so0 = vf0, so1 = vf0;
                    if (seg) { so0 = pack8(S[kt], 0); so1 = pack8(S[kt], 1); }
                    HG_RD(2 * kt + 1, kB, aB, qB, tB);
                    if (seg) { pT = MFMA32(kA, aA, pT); o = MFMA32(qA, so0, o); }
                    S[kt] = MFMA32(tA, vf0, S[kt]);
                    if (kt < 3) HG_RD(2 * kt + 2, kA, aA, qA, tA);
                    if (seg) { pT = MFMA32(kB, aB, pT); o = MFMA32(qB, so1, o); }
                    S[kt] = MFMA32(tB, vf1, S[kt]);
                    if (kt > 0) {
#pragma unroll
                        for (int gq = 0; gq < 4; ++gq) { const f32x4 d4 = *(const LAS f32x4*)(dv + 32 * (kt - 1) + 8 * gq + 4 * hi);
                            S[kt - 1][4 * gq] *= d4.x; S[kt - 1][4 * gq + 1] *= d4.y; S[kt - 1][4 * gq + 2] *= d4.z; S[kt - 1][4 * gq + 3] *= d4.w; } }
                }
#undef HG_RD
                if (seg) {
#pragma unroll
                    for (int i = 0; i < 16; ++i) { const int si = crow(i, hi); const bool keep = dir ? (si >= l32) : (si <= l32); pT[i] = keep ? pT[i] : 0.f; }
                    const bf16x8 pf0 = pack8(pT, 0), pf1 = pack8(pT, 1);
                    o = MFMA32(pf0, vf0, o); o = MFMA32(pf1, vf1, o);
#pragma unroll
                    for (int i = 0; i < 16; ++i) ob[i] = f2bf(o[i]);
                    ob_t0 = t0; have_ob = true;
                }
#pragma unroll
                for (int gq = 0; gq < 4; ++gq) { const f32x4 d4 = *(const LAS f32x4*)(dv + 96 + 8 * gq + 4 * hi);
                    S[3][4 * gq] *= d4.x; S[3][4 * gq + 1] *= d4.y; S[3][4 * gq + 2] *= d4.z; S[3][4 * gq + 3] *= d4.w; }
            }
            asm volatile("s_waitcnt lgkmcnt(0)\n\ts_barrier" ::: "memory");
        }
        if (have_ob) { bf16* op = OD + (size_t)(b * SEQ + ob_t0) * 1024 + h * 128 + 32 * wave + l32;
#pragma unroll
            for (int i = 0; i < 16; ++i) op[(size_t)crow(i, hi) * 1024] = (bf16)ob[i]; }
    }
#undef HG_T0
#undef HG_LOAD_GATE
#undef HG_SUMS
#undef HG_LOAD_V
}

#define RLX_AGENT __ATOMIC_RELAXED, __HIP_MEMORY_SCOPE_AGENT
#define XB_TMO      128
#define XB_XCNT(j)  (256  + 64 * (j))
#define XB_XSUB(j)  (1280 + 64 * (j))
#define XB_XGEN(j)  (2304 + 64 * (j))
#define XB_TOP      3328
#define XB_TOPGEN   3392
#define XCD_BAR_WORDS 3456
#define XB_SPIN_CAP (1u << 18)

__device__ __forceinline__ unsigned xb_ld(unsigned* p)              { return __hip_atomic_load(p, __ATOMIC_RELAXED, __HIP_MEMORY_SCOPE_AGENT); }
__device__ __forceinline__ unsigned xb_add(unsigned* p, unsigned v) { return __hip_atomic_fetch_add(p, v, __ATOMIC_RELAXED, __HIP_MEMORY_SCOPE_AGENT); }
__device__ __forceinline__ unsigned xb_xcc_id() { return (unsigned)__builtin_amdgcn_s_getreg((3 << 11) | 20) & 0xFu; }
#define XB_SPIN(cond, bar) do { unsigned _sp = 0; while (cond) { __builtin_amdgcn_s_sleep(1); \
    if ((++_sp & 255u) == 0u) { if (xb_ld(&(bar)[XB_TMO])) break; if (_sp > XB_SPIN_CAP) { atomicAdd(&(bar)[XB_TMO], 1u); break; } } } } while (0)

struct XcdBarrier {
    unsigned* bar; unsigned x;
    volatile LAS unsigned* st;
};

__device__ __forceinline__ XcdBarrier xcd_barrier_post(unsigned* bar, volatile LAS unsigned* st) {
    XcdBarrier b; b.bar = bar; b.x = xb_xcc_id(); b.st = st;
    if (threadIdx.x == 0) (void)xb_add(&bar[XB_XCNT(b.x)], 1u);
    return b;
}
__device__ __forceinline__ void xcd_barrier_complete(unsigned* bar, unsigned x, unsigned& nloc, unsigned& nx) {
    const unsigned G = gridDim.x * gridDim.y * gridDim.z;
    unsigned sum, cnt, mine, sp = 0u;
    for (;;) {
        sum = 0u; cnt = 0u; mine = 0u;
#pragma unroll
        for (unsigned j = 0; j < 16; ++j) { const unsigned c = xb_ld(&bar[XB_XCNT(j)]); sum += c; cnt += (c > 0u) ? 1u : 0u; mine = (j == x) ? c : mine; }
        if (sum == G) break;
        __builtin_amdgcn_s_sleep(1);
        if ((++sp & 255u) == 0u) { if (xb_ld(&bar[XB_TMO])) break; if (sp > XB_SPIN_CAP) { atomicAdd(&bar[XB_TMO], 1u); break; } }
    }
    nloc = mine > 0u ? mine : 1u; nx = cnt > 0u ? cnt : 1u;
}

__device__ __forceinline__ void xcd_barrier(const XcdBarrier& b) {
    asm volatile("s_waitcnt vmcnt(0)" ::: "memory");
    __syncthreads();
    if (threadIdx.x == 0) {
        unsigned* bar = b.bar;
        __builtin_amdgcn_s_waitcnt(0);
        unsigned nloc = b.st[0], nx = b.st[1];
        if (nloc == 0u) { xcd_barrier_complete(bar, b.x, nloc, nx); b.st[0] = nloc; b.st[1] = nx; }
        const unsigned old = xb_add(&bar[XB_XSUB(b.x)], 1u);
        const unsigned gen = old / nloc;
        if (old + 1u == (gen + 1u) * nloc) {
            __builtin_amdgcn_fence(__ATOMIC_RELEASE, "agent");
            asm volatile("s_waitcnt vmcnt(0)" ::: "memory");
            const unsigned og = xb_add(&bar[XB_TOP], 1u);
            const unsigned tg = og / nx;
            if (og + 1u == (tg + 1u) * nx) xb_add(&bar[XB_TOPGEN], 1u);
            else XB_SPIN(xb_ld(&bar[XB_TOPGEN]) == tg, bar);
            __builtin_amdgcn_fence(__ATOMIC_ACQUIRE, "agent");
            xb_add(&bar[XB_XGEN(b.x)], 1u);
            asm volatile("s_waitcnt vmcnt(0)" ::: "memory");
        } else {
            XB_SPIN(xb_ld(&bar[XB_XGEN(b.x)]) == gen, bar);
            __builtin_amdgcn_fence(__ATOMIC_ACQUIRE, "agent");
            asm volatile("s_waitcnt vmcnt(0)" ::: "memory");
        }
    }
    __syncthreads();
}

__global__ void __launch_bounds__(512, 2) fwd_mega(Args args) {
    extern __shared__ __attribute__((aligned(16))) unsigned char lds_raw[];
    LAS unsigned char* lds = (LAS unsigned char*)lds_raw;
    cg::grid_group grid = cg::this_grid();
    const int tid = threadIdx.x, lane_k = tid & 63, wave = __builtin_amdgcn_readfirstlane(tid >> 6);
    const int G = gridDim.x, bx = blockIdx.x;
    const int gw = bx * 8 + wave, NGW = G * 8;
    unsigned char* ws = args.ws;
    const float* x = args.in[0]; const float* cvec = args.in[1]; const float* ctx = args.in[2]; const float* cctx = args.in[3];
    const float* w_ada = args.in[4]; const float* b_ada = args.in[5]; const float* norm1_g = args.in[6]; const float* w_in = args.in[7];
    const float* na_rpb = args.in[8]; const float* lbl = args.in[9]; const float* hg_g = args.in[10];
    const float* w_pa = args.in[11]; const float* w_pb = args.in[12]; const float* w_out = args.in[13]; const float* norm2_g = args.in[14];
    const float* w_f1 = args.in[15]; const float* w_f2 = args.in[16]; const float* final_g = args.in[17];
    float* out = args.out; unsigned char* outb = (unsigned char*)args.out;
    float* modall = (float*)(ws + WS_MOD); float* part = (float*)(ws + WS_PART);
    bf16* Wint = (bf16*)(ws + WS_WIN); bf16* Wpat = (bf16*)(ws + WS_WPA); bf16* Wpbt = (bf16*)(ws + WS_WPB); bf16* Woutt = (bf16*)(ws + WS_WOUT);
    bf16* Wf1t = (bf16*)(ws + WS_WF1); bf16* Wf2t = (bf16*)(ws + WS_WF2);
    bf16* UC1 = (bf16*)(ws + WS_UC1); bf16* KHC = (bf16*)(ws + WS_KHC); bf16* QKH = (bf16*)(ws + WS_QKH); bf16* VTC = (bf16*)(ws + WS_VTC); bf16* HC = (bf16*)(ws + WS_HC); bf16* U1 = (bf16*)(ws + WS_U1); bf16* VT = (bf16*)(ws + WS_VT);
    bf16* YM = (bf16*)(ws + WS_YM); bf16* H2 = (bf16*)(ws + WS_H2); bf16* HID = (bf16*)(ws + WS_HID);
    bf16* Hb = (bf16*)(outb + DO_H); bf16* ONA = (bf16*)(outb + DO_ONA); bf16* OF = (bf16*)(outb + DO_OF); bf16* OB = (bf16*)(ws + WS_OB); bf16* OHG = (bf16*)(outb + DO_OHG);
    const int lo = args.ph_lo, hi_ = args.ph_hi;
    if (tid < 64) ((LAS unsigned*)(lds + LDS_MISC))[tid] = 0u;
    __syncthreads();
    XcdBarrier xbar; xbar.bar = (unsigned*)(ws + WS_BAR); xbar.x = 0; xbar.st = nullptr;
    if (USE_XCD_BAR) xbar = xcd_barrier_post((unsigned*)(ws + WS_BAR), (volatile LAS unsigned*)(lds + LDS_MISC) + 8);
#define IN(k) (lo <= (k) && (k) < hi_)
#define SEAM(k) do { if (IN(k) && IN((k) + 1)) { if (!USE_XCD_BAR || lo < 0) grid.sync(); else xcd_barrier(xbar); } } while (0)

    if (IN(0)) {
        int lane = lane_k; asm volatile("" : "+v"(lane));
        LAS float* sv = (LAS float*)lds;
        for (int item = bx; item < 192; item += G) {
            const int kpart = item / 6, cgp = (item % 6) * 512 + tid;
            if (tid < 320) { const int v = tid >> 6, kk = tid & 63, kx = kpart * 64 + kk; const float cv = (v < 4) ? cvec[v * DM + kx] : cctx[kx]; sv[v * 64 + kk] = cv * sigm(cv); }
            __syncthreads();
            f32x4 acc[5];
#pragma unroll
            for (int v = 0; v < 5; ++v) acc[v] = (f32x4){0.f, 0.f, 0.f, 0.f};
            const float* wp = w_ada + (size_t)(kpart * 64) * NMOD + 4 * cgp;
#pragma unroll 4
            for (int kk = 0; kk < 64; ++kk) { const f32x4 w = __builtin_nontemporal_load((const f32x4*)(wp + (size_t)kk * NMOD));
#pragma unroll
                for (int v = 0; v < 5; ++v) acc[v] += w * sv[v * 64 + kk]; }
#pragma unroll
            for (int v = 0; v < 5; ++v) *(f32x4*)(part + (size_t)(kpart * 5 + v) * NMOD + 4 * cgp) = acc[v];
            __syncthreads();
        }
        LAS float* scr = (LAS float*)(lds + 4096 + wave * 16384);
        constexpr int I_IN = 32 * 384, I_PA = 16 * 64, I_OUT = 32 * 64, I_F1 = 32 * 352, I_F2 = 88 * 64;
        constexpr int NIT = I_IN + 2 * I_PA + I_OUT + I_F1 + I_F2;
        for (int it = gw; it < NIT; it += NGW) {
            int r = it;
            if (r < I_IN) { const int kb = r / 384, nb = r % 384, n0 = 32 * nb; transpose_item(w_in, DM, NIN, Wint, 64 * kb, n0, kInRowMap[n0 >> 10] + (n0 & 1023), scr, lane); continue; } r -= I_IN;
            if (r < I_PA) { const int kb = r / 64, nb = r % 64; transpose_item(w_pa, 1024, DM, Wpat, 64 * kb, 32 * nb, 32 * nb, scr, lane); continue; } r -= I_PA;
            if (r < I_PA) { const int kb = r / 64, nb = r % 64; transpose_item(w_pb, 1024, DM, Wpbt, 64 * kb, 32 * nb, 32 * nb, scr, lane); continue; } r -= I_PA;
            if (r < I_OUT) { const int kb = r / 64, nb = r % 64; transpose_item(w_out, DM, DM, Woutt, 64 * kb, 32 * nb, 32 * nb, scr, lane); continue; } r -= I_OUT;
            if (r < I_F1) { const int kb = r / 352, nb = r % 352, n0 = 32 * nb; const int isu = n0 >= FFH, j = n0 - isu * FFH;
                transpose_item(w_f1, DM, 2 * FFH, Wf1t, 64 * kb, n0, (j >> 7) * 256 + isu * 128 + (j & 127), scr, lane); continue; } r -= I_F1;
            { const int kb = r / 64, nb = r % 64; transpose_item(w_f2, FFH, DM, Wf2t, 64 * kb, 32 * nb, 32 * nb, scr, lane); }
        }
    }
    SEAM(0);
    if (IN(1)) {
        for (int i = bx * 512 + tid; i < 5 * NMOD; i += G * 512) { const int v = i / NMOD, n = i % NMOD; float s = b_ada[n];
            for (int kp = 0; kp < 32; ++kp) s += part[(size_t)(kp * 5 + v) * NMOD + n];
            modall[i] = s; }
    }
    SEAM(1);
    if (IN(2)) {
        int lane = lane_k; asm volatile("" : "+v"(lane));
        for (int m = 2 * gw; m < M + MC; m += 2 * NGW) {
            if (m < M) { const int b = m >> 13; norm_row2<true, false>(x + (size_t)m * DM, x + (size_t)(m + 1) * DM, norm1_g, modall + b * NMOD + DM, modall + b * NMOD, Hb + (size_t)m * DM, Hb + (size_t)(m + 1) * DM, nullptr, nullptr, lane); }
            else { const int mc = m - M; norm_row2<true, false>(ctx + (size_t)mc * DM, ctx + (size_t)(mc + 1) * DM, norm1_g, modall + 4 * NMOD + DM, modall + 4 * NMOD, HC + (size_t)mc * DM, HC + (size_t)(mc + 1) * DM, nullptr, nullptr, lane); }
        }
    }
    SEAM(2);
    if (IN(3)) {
        const bool fill = (G == 256);
        for (int gi = 0; gi < (fill ? 5 : 4); ++gi) {
            pg8::Gemm g; pg8::EpiStore E;
            if (gi == 4) { g = pg8::Gemm{Hb, Wint + (size_t)W_NOW * DM, M, 10240 - W_NOW, DM}; E = pg8::EpiStore{U1 + C_GA, U1W, nullptr, 0, 0, 0, 0, lbl, 0, 0}; }
            else if (gi == 0) { g = pg8::Gemm{Hb, Wint, M, W_NOW, DM}; E = pg8::EpiStore{U1, U1W, QKH, 1024, 3072, M, 0, lbl, 3072, 5120}; }
            else if (gi == 1) { g = pg8::Gemm{Wint + (size_t)10240 * DM, Hb, 2048, M, DM}; E = pg8::EpiStore{VT, 2048, nullptr, 0, 0, 0, 1, lbl, 0, 0}; }
            else if (gi == 2) { g = pg8::Gemm{HC, Wint + (size_t)2048 * DM, MC, 3072, DM}; E = pg8::EpiStore{UC1, UC1W, KHC, 0, 1024, MC, 0, lbl, 1024, 3072}; }
            else { g = pg8::Gemm{Wint + (size_t)10240 * DM, HC, 2048, MC, DM}; E = pg8::EpiStore{VTC, 2048, nullptr, 0, 0, 0, 1, lbl, 0, 0}; }
            pg8::StaticOrder S; S.init(g.M, g.N, G, (gi == 3 && G >= 128) ? (bx + G - 48) % G : bx);
            if (gi == 4) { if (bx >= 80) S.init2(g.M, g.N, G - 80, bx - 80, 0, GU_FILL); else S.init2(g.M, g.N, 1, 0, 0, 0); }
            pg8::gemm_phase<pg8::EpiStore, pg8::StaticOrder, true, true>(lds, g, S, E);
        }
    }
    SEAM(3);
    if (IN(4)) {
        const int nh = (G >= 128) ? 64 : 0;
        if (bx < nh || nh == 0) {
            for (int item = bx; item < 64; item += (nh ? nh : G)) hgrn_item(item, lbl, U1, UC1, VT, VTC, OF, OB, lds);
            if (nh) {
                pg8::Gemm g{Hb, Wint + (size_t)W_NOW * DM, M, 10240 - W_NOW, DM}; pg8::EpiStore E{U1 + C_GA, U1W, nullptr, 0, 0, 0, 0, lbl, 0, 0};
                pg8::StaticOrder S; S.init2(g.M, g.N, nh, bx, (G == 256) ? GU_SPLIT2 : GU_SPLIT, 1 << 30);
                pg8::gemm_phase<pg8::EpiStore, pg8::StaticOrder, true, true>(lds, g, S, E);
            }
        }
        if (bx >= nh) {
            int lane = lane_k; asm volatile("" : "+v"(lane));
            LAS float* rpb = (LAS float*)lds;
            for (int i = tid; i < RPB_FLOATS; i += 512) { const int j = i - RPB_OFF; rpb[i] = (i >= RPB_NINF) ? -INFINITY : (j >= 0 && j < 16 * 15 * 31) ? na_rpb[j] * LOG2E : 0.f; }
            __syncthreads();
            const int nwv = (G - nh) * 8;
            for (int task = (bx - nh) * 8 + wave; task < 16384; task += nwv) na_task(task, QKH, KHC, VT, VTC, ONA, rpb, (LAS float*)(lds + 32768 + wave * 8192), lane);
            __syncthreads();
            pg8::Gemm g{Hb, Wint + (size_t)W_NOW * DM, M, 10240 - W_NOW, DM}; pg8::EpiStore E{U1 + C_GA, U1W, nullptr, 0, 0, 0, 0, lbl, 0, 0};
            pg8::StaticOrder S; S.init2(g.M, g.N, G - nh, bx - nh, (G == 256) ? GU_FILL : 0, nh ? ((G == 256) ? GU_SPLIT2 : GU_SPLIT) : (1 << 30));
            pg8::gemm_phase<pg8::EpiStore, pg8::StaticOrder, true, true>(lds, g, S, E);
        }
    }
    SEAM(4);
    if (IN(5)) {
        int lane = lane_k; asm volatile("" : "+v"(lane));
        for (int m = gw; m < M; m += NGW) {
            const size_t o = (size_t)m * 1024 + 16 * lane;
            const u32x4 a0 = __builtin_nontemporal_load((const u32x4*)(OF + o)), a1 = __builtin_nontemporal_load((const u32x4*)(OF + o + 8)), b0 = __builtin_nontemporal_load((const u32x4*)(OB + o)), b1 = __builtin_nontemporal_load((const u32x4*)(OB + o + 8));
            const u32x4 g0 = *(const u32x4*)(U1 + (size_t)m * U1W + C_HOG + 16 * lane), g1 = *(const u32x4*)(U1 + (size_t)m * U1W + C_HOG + 16 * lane + 8);
            float v[16], gg[16];
#pragma unroll
            for (int i = 0; i < 4; ++i) { v[2 * i] = pg8::bflo(a0[i]) + pg8::bflo(b0[i]); v[2 * i + 1] = pg8::bfhi(a0[i]) + pg8::bfhi(b0[i]);
                v[8 + 2 * i] = pg8::bflo(a1[i]) + pg8::bflo(b1[i]); v[8 + 2 * i + 1] = pg8::bfhi(a1[i]) + pg8::bfhi(b1[i]);
                gg[2 * i] = pg8::bflo(g0[i]); gg[2 * i + 1] = pg8::bfhi(g0[i]); gg[8 + 2 * i] = pg8::bflo(g1[i]); gg[8 + 2 * i + 1] = pg8::bfhi(g1[i]); }
            float ss = 0.f;
#pragma unroll
            for (int i = 0; i < 16; ++i) ss += v[i] * v[i];
            ss += __shfl_xor(ss, 1); ss += __shfl_xor(ss, 2); ss += __shfl_xor(ss, 4);
            const float rstd = 1.0f / sqrtf(ss * (1.0f / 128.0f) + EPS);
            const float* gp = hg_g + 16 * (lane & 7);
            float y[16];
#pragma unroll
            for (int i = 0; i < 16; ++i) y[i] = v[i] * rstd * gp[i] * (gg[i] * pg8::sigm(gg[i]));
            u32x4 w0, w1; w0.x = pk2(y[0], y[1]); w0.y = pk2(y[2], y[3]); w0.z = pk2(y[4], y[5]); w0.w = pk2(y[6], y[7]);
            w1.x = pk2(y[8], y[9]); w1.y = pk2(y[10], y[11]); w1.z = pk2(y[12], y[13]); w1.w = pk2(y[14], y[15]);
            *(u32x4*)(OHG + o) = w0; *(u32x4*)(OHG + o + 8) = w1;
        }
    }
    SEAM(5);
    if (IN(6)) {
        for (int gi = 0; gi < 2; ++gi) {
            pg8::Gemm g = gi ? pg8::Gemm{OHG, Wpbt, M, DM, 1024} : pg8::Gemm{ONA, Wpat, M, DM, 1024};
            pg8::EpiMerge E{YM, DM, U1 + (gi ? C_GB : C_GA), U1W, gi};
            pg8::StaticOrder S; S.init(M, DM, G, bx);
            pg8::gemm_phase<pg8::EpiMerge, pg8::StaticOrder, true, true>(lds, g, S, E);
        }
    }
    SEAM(6);
    if (IN(7)) {
        pg8::Gemm g{YM, Woutt, M, DM, DM}; pg8::EpiRes E{x, out, modall + 2 * DM};
        pg8::StaticOrder S; S.init(M, DM, G, bx);
        pg8::gemm_phase<pg8::EpiRes, pg8::StaticOrder, true, true>(lds, g, S, E);
    }
    SEAM(7);
    if (IN(8)) {
        int lane = lane_k; asm volatile("" : "+v"(lane));
        for (int m = 2 * gw; m < M; m += 2 * NGW) { const int b = m >> 13; norm_row2<false, false>(out + (size_t)m * DM, out + (size_t)(m + 1) * DM, norm2_g, modall + b * NMOD + 4 * DM, modall + b * NMOD + 3 * DM, H2 + (size_t)m * DM, H2 + (size_t)(m + 1) * DM, nullptr, nullptr, lane); }
    }
    SEAM(8);
    if (IN(9)) {
        pg8::Gemm g{H2, Wf1t, M, 2 * FFH, DM}; pg8::EpiSwiglu E{HID, FFH};
        pg8::StaticOrder S; S.init(M, 2 * FFH, G, bx);
        pg8::gemm_phase<pg8::EpiSwiglu, pg8::StaticOrder, true, true>(lds, g, S, E);
    }
    SEAM(9);
    if (IN(10)) {
        pg8::Gemm g{HID, Wf2t, M, DM, FFH}; pg8::EpiRes E{out, out, modall + 5 * DM};
        pg8::StaticOrder S; S.init(M, DM, G, bx);
        pg8::gemm_phase<pg8::EpiRes, pg8::StaticOrder, true, true>(lds, g, S, E);
    }
    SEAM(10);
    if (IN(11)) {
        int lane = lane_k; asm volatile("" : "+v"(lane));
        for (int m = 2 * gw; m < M; m += 2 * NGW) norm_row2<false, true>(out + (size_t)m * DM, out + (size_t)(m + 1) * DM, final_g, nullptr, nullptr, nullptr, nullptr, out + (size_t)m * DM, out + (size_t)(m + 1) * DM, lane);
    }
#undef IN
#undef SEAM
}

#ifndef MK_SPLIT
#define MK_SPLIT 0
#endif
extern "C" void kernel_launch(void* const* d_in, const int* in_sizes, int n_in, void* d_out, int out_size, void* d_ws, size_t ws_size, hipStream_t stream) {
    static int grid = 0;
    if (grid == 0) {
        if (n_in != 18 || out_size != M * DM || ws_size < WS_END) { fprintf(stderr, "kernel_launch: unexpected shapes (n_in %d out %d ws %zu)\n", n_in, out_size, ws_size); grid = -1; return; }
        int dev = 0, cus = 0, per_cu = 0;
        (void)hipGetDevice(&dev); (void)hipDeviceGetAttribute(&cus, hipDeviceAttributeMultiprocessorCount, dev);
        if (hipFuncSetAttribute((const void*)fwd_mega, hipFuncAttributeMaxDynamicSharedMemorySize, LDS_BYTES) != hipSuccess) { fprintf(stderr, "kernel_launch: hipFuncSetAttribute failed\n"); grid = -1; return; }
        if (hipOccupancyMaxActiveBlocksPerMultiprocessor(&per_cu, (const void*)fwd_mega, 512, LDS_BYTES) != hipSuccess || per_cu < 1) { fprintf(stderr, "kernel_launch: occupancy query says %d\n", per_cu); per_cu = 1; }
        (void)hipGetLastError();
        grid = cus * per_cu;
        fprintf(stderr, "kernel_launch: grid %d (cus %d x %d), ws %zu\n", grid, cus, per_cu, ws_size);
    }
    if (grid < 0) return;
    if (USE_XCD_BAR && hipMemsetAsync((char*)d_ws + WS_BAR, 0, BAR_BYTES, stream) != hipSuccess) { fprintf(stderr, "kernel_launch: hipMemsetAsync of the barrier words failed\n"); return; }
    Args a{};
    for (int i = 0; i < 18; ++i) a.in[i] = (const float*)d_in[i];
    a.out = (float*)d_out; a.ws = (unsigned char*)d_ws;
#if MK_SPLIT
    for (int p = 0; p < NPH; ++p) { a.ph_lo = p; a.ph_hi = p + 1; void* kargs[] = {&a};
        hipError_t e = hipLaunchCooperativeKernel((const void*)fwd_mega, dim3(grid), dim3(512), kargs, LDS_BYTES, stream);
        if (e != hipSuccess) { fprintf(stderr, "kernel_launch: launch %d failed: %s\n", p, hipGetErrorString(e)); break; } }
#else
    a.ph_lo = 0; a.ph_hi = NPH; void* kargs[] = {&a};
    hipError_t e = hipLaunchCooperativeKernel((const void*)fwd_mega, dim3(grid), dim3(512), kargs, LDS_BYTES, stream);
    if (e != hipSuccess) fprintf(stderr, "kernel_launch: cooperative launch failed: %s (grid %d)\n", hipGetErrorString(e), grid);
#endif
}
```

```cpp
#include <hip/hip_runtime.h>
#include <hip/hip_cooperative_groups.h>
#include <cstdio>
#include <cstdint>
namespace cg = cooperative_groups;
namespace pg8 {
#define PG8_LAS __attribute__((address_space(3)))
typedef unsigned short bf16_t;
typedef short bf16x8 __attribute__((ext_vector_type(8)));
typedef float f32x4 __attribute__((ext_vector_type(4)));
typedef unsigned u32x4 __attribute__((ext_vector_type(4)));
constexpr int BM = 256, BK = 64, HALF = 128, HTB = HALF * BK * 2  , STAGE_BYTES = 8 * HTB, NXCD = 8, WGM = 8;

__host__ __device__ __forceinline__ int lds_byte(int r, int c) { const int st = (r >> 4) * 2 + (c >> 5), rr = r & 15, cc = c & 31, ob = rr * 64 + cc * 2; return st * 1024 + (ob ^ (((ob >> 9) & 1) << 5)); }
__host__ __device__ __forceinline__ void stage_rc(int b, int& R, int& C) { const int st = b / 1024, sb = b % 1024, swz = sb ^ (((sb >> 9) & 1) << 5); R = (st >> 1) * 16 + swz / 64; C = (st & 1) * 32 + (swz % 64) / 2; }
__host__ __device__ __forceinline__ int perm32(int rho) { const int n = rho >> 4, i = rho & 15; return 8 * (i >> 2) + 4 * n + (i & 3); }

struct Unit { int pm, pn; };
struct Gemm { const bf16_t* A; const bf16_t* Bt; int M, N, K; };

struct StaticOrder {
    int nM, nN, nwg, G, c, base, lim;
    __host__ __device__ void init(int M, int N, int G_, int c_) { nM = M / BM; nN = N / BM; nwg = nM * nN; G = G_; c = c_; base = 0; lim = nwg; }
    __host__ __device__ void init2(int M, int N, int G_, int c_, int base_, int lim_) { init(M, N, G_, c_); base = base_; lim = lim_ < nwg ? lim_ : nwg; }
    __host__ __device__ bool next(int i, Unit& u) const {
        const long L = (long)base + (long)i * G + c; if (L >= lim) return false;
        int wgid = (int)L; { const int q = nwg / NXCD, r = nwg % NXCD, xcd = wgid % NXCD, off = wgid / NXCD; wgid = (xcd < r ? xcd * (q + 1) : r * (q + 1) + (xcd - r) * q) + off; }
        const int nig = WGM * nN, gid = wgid / nig, fm = gid * WGM, gsz = (nM - fm) < WGM ? (nM - fm) : WGM;
        u.pm = fm + ((wgid % nig) % gsz); u.pn = (wgid % nig) / gsz; return true;
    }
    __device__ __forceinline__ void a_ready(const Unit&) const {}
    __device__ __forceinline__ void done(const Unit&) const {}
};

__device__ __forceinline__ unsigned cvt_pk_bf16(float lo, float hi) { unsigned r; asm volatile("v_cvt_pk_bf16_f32 %0, %1, %2" : "=v"(r) : "v"(lo), "v"(hi)); return r; }
typedef float f32x2c __attribute__((ext_vector_type(2))); typedef __bf16 bf16x2c __attribute__((ext_vector_type(2)));
__device__ __forceinline__ unsigned cvt_pk_bf16_c(float lo, float hi) { f32x2c v = {lo, hi}; bf16x2c b = __builtin_convertvector(v, bf16x2c); return __builtin_bit_cast(unsigned, b); }
__device__ __forceinline__ float bflo(unsigned u) { return __uint_as_float(u << 16); }
__device__ __forceinline__ float bfhi(unsigned u) { return __uint_as_float(u & 0xffff0000u); }
__device__ __forceinline__ float sigm(float x) { return __builtin_amdgcn_rcpf(1.0f + __expf(-x)); }
struct EpiStore {
    static constexpr bool PERM = true, AFTER_DRAIN = false;
    bf16_t* O; int ldc; bf16_t* HM; int hm_lo, hm_hi, hm_rows, mode; const float* lbl; int g_lo, g_hi;
    __device__ __forceinline__ void operator()(const f32x4 (&acc)[2][2][4][2], const Unit& u, int wr, int wc, int fr, int fq) const {
        const int row0 = u.pm * BM + wr * 64 + fr; const int colt = u.pn * BM;
        bf16_t* p0; size_t rstride, bjstride;
        if (mode == 1) { rstride = 32; p0 = O + ((size_t)(colt / 32 + wc) * ldc + row0) * 32 + 8 * fq; bjstride = (size_t)4 * ldc * 32; }
        else if (colt >= hm_lo && colt < hm_hi) { rstride = 64; p0 = HM + ((size_t)((colt - hm_lo) / 64 + (wc >> 1)) * hm_rows + row0) * 64 + (wc & 1) * 32 + 8 * fq; bjstride = (size_t)2 * hm_rows * 64; }
        else { rstride = ldc; p0 = O + (size_t)row0 * ldc + (colt - (colt >= hm_hi ? hm_hi - hm_lo : 0)) + wc * 32 + 8 * fq; bjstride = HALF; }
        if (mode == 0 && colt >= g_lo && colt < g_hi) {
            float lb[2][8];
#pragma unroll
            for (int bj = 0; bj < 2; ++bj)
#pragma unroll
                for (int e = 0; e < 8; ++e) { const int c = colt - g_lo + bj * HALF + wc * 32 + 8 * fq + e; lb[bj][e] = sigm(lbl[c] - lbl[2048 + c]); }
#pragma unroll
            for (int ai = 0; ai < 2; ++ai)
#pragma unroll
                for (int m = 0; m < 4; ++m) { bf16_t* rowp = p0 + (size_t)(ai * HALF + m * 16) * rstride;
#pragma unroll
                    for (int bj = 0; bj < 2; ++bj) { float o[8];
#pragma unroll
                        for (int e = 0; e < 8; ++e) { const float v = fminf(fmaxf(acc[ai][bj][m][e >> 2][e & 3], -30.f), 30.f); const float sg = __builtin_amdgcn_rcpf(1.0f + __expf(-v)); o[e] = __log2f(lb[bj][e] + (1.0f - lb[bj][e]) * sg); }
                        u32x4 w; w.x = cvt_pk_bf16_c(o[0], o[1]); w.y = cvt_pk_bf16_c(o[2], o[3]); w.z = cvt_pk_bf16_c(o[4], o[5]); w.w = cvt_pk_bf16_c(o[6], o[7]);
                        *(u32x4*)(rowp + bj * bjstride) = w; } }
            return;
        }
#pragma unroll
        for (int ai = 0; ai < 2; ++ai)
#pragma unroll
            for (int m = 0; m < 4; ++m) { bf16_t* rowp = p0 + (size_t)(ai * HALF + m * 16) * rstride;
#pragma unroll
                for (int bj = 0; bj < 2; ++bj) { const f32x4 v0 = acc[ai][bj][m][0], v1 = acc[ai][bj][m][1];
                    u32x4 w; w.x = cvt_pk_bf16(v0[0], v0[1]); w.y = cvt_pk_bf16(v0[2], v0[3]); w.z = cvt_pk_bf16(v1[0], v1[1]); w.w = cvt_pk_bf16(v1[2], v1[3]);
                    *(u32x4*)(rowp + bj * bjstride) = w; } }
    }
};
struct EpiMerge {
    static constexpr bool PERM = true, AFTER_DRAIN = false;
    bf16_t* Y; int ldy; const bf16_t* G; int ldg; int accum;
    __device__ __forceinline__ void operator()(const f32x4 (&acc)[2][2][4][2], const Unit& u, int wr, int wc, int fr, int fq) const {
        const int row0 = u.pm * BM + wr * 64 + fr; const int col0 = u.pn * BM + wc * 32 + 8 * fq;
#pragma unroll
        for (int ai = 0; ai < 2; ++ai)
#pragma unroll
            for (int m = 0; m < 4; ++m) { const size_t row = (size_t)(row0 + ai * HALF + m * 16);
#pragma unroll
                for (int bj = 0; bj < 2; ++bj) { const f32x4 v0 = acc[ai][bj][m][0], v1 = acc[ai][bj][m][1];
                    const u32x4 gq = *(const u32x4*)(G + row * ldg + col0 + bj * HALF);
                    u32x4 pv = (u32x4){0u, 0u, 0u, 0u}; if (accum) pv = *(const u32x4*)(Y + row * ldy + col0 + bj * HALF);
                    float o[8];
                    o[0] = sigm(bflo(gq.x)) * v0[0] + bflo(pv.x); o[1] = sigm(bfhi(gq.x)) * v0[1] + bfhi(pv.x);
                    o[2] = sigm(bflo(gq.y)) * v0[2] + bflo(pv.y); o[3] = sigm(bfhi(gq.y)) * v0[3] + bfhi(pv.y);
                    o[4] = sigm(bflo(gq.z)) * v1[0] + bflo(pv.z); o[5] = sigm(bfhi(gq.z)) * v1[1] + bfhi(pv.z);
                    o[6] = sigm(bflo(gq.w)) * v1[2] + bflo(pv.w); o[7] = sigm(bfhi(gq.w)) * v1[3] + bfhi(pv.w);
                    u32x4 w; w.x = cvt_pk_bf16(o[0], o[1]); w.y = cvt_pk_bf16(o[2], o[3]); w.z = cvt_pk_bf16(o[4], o[5]); w.w = cvt_pk_bf16(o[6], o[7]);
                    *(u32x4*)(Y + row * ldy + col0 + bj * HALF) = w; } }
    }
};
struct EpiRes {
    static constexpr bool PERM = false, AFTER_DRAIN = false;
    const float* base; float* out; const float* gate;
    __device__ __forceinline__ void operator()(const f32x4 (&acc)[2][2][4][2], const Unit& u, int wr, int wc, int fr, int fq) const {
        const int b = (u.pm * BM) >> 13; const float* gp = gate + (size_t)b * 12288;
        const int col0 = u.pn * BM + wc * 32 + 4 * fq;
        f32x4 gv[2][2];
#pragma unroll
        for (int bj = 0; bj < 2; ++bj)
#pragma unroll
            for (int n = 0; n < 2; ++n) gv[bj][n] = *(const f32x4*)(gp + col0 + bj * HALF + n * 16);
#pragma unroll
        for (int ai = 0; ai < 2; ++ai)
#pragma unroll
            for (int m = 0; m < 4; ++m) { const size_t off = (size_t)(u.pm * BM + ai * HALF + wr * 64 + m * 16 + fr) * 2048 + col0;
#pragma unroll
                for (int bj = 0; bj < 2; ++bj)
#pragma unroll
                    for (int n = 0; n < 2; ++n) { const f32x4 bs = *(const f32x4*)(base + off + bj * HALF + n * 16);
                        *(f32x4*)(out + off + bj * HALF + n * 16) = bs + gv[bj][n] * acc[ai][bj][m][n]; }
                if (m & 1) asm volatile("" ::: "memory"); }
    }
};
struct EpiSwiglu {
    static constexpr bool PERM = true, AFTER_DRAIN = false;
    bf16_t* H; int ldc;
    __device__ __forceinline__ void operator()(const f32x4 (&acc)[2][2][4][2], const Unit& u, int wr, int wc, int fr, int fq) const {
        const int row0 = u.pm * BM + wr * 64 + fr; const int col0 = u.pn * HALF + wc * 32 + 8 * fq;
#pragma unroll
        for (int ai = 0; ai < 2; ++ai)
#pragma unroll
            for (int m = 0; m < 4; ++m) { bf16_t* rowp = H + (size_t)(row0 + ai * HALF + m * 16) * ldc + col0;
                float o[8];
#pragma unroll
                for (int n = 0; n < 2; ++n)
#pragma unroll
                    for (int i = 0; i < 4; ++i) { const float a = acc[ai][0][m][n][i], g = acc[ai][1][m][n][i]; o[4 * n + i] = a * sigm(a) * g; }
                u32x4 w; w.x = cvt_pk_bf16(o[0], o[1]); w.y = cvt_pk_bf16(o[2], o[3]); w.z = cvt_pk_bf16(o[4], o[5]); w.w = cvt_pk_bf16(o[6], o[7]);
                *(u32x4*)rowp = w; }
    }
};
template <class Epi, class Sched, bool ALIGN_EPI = false, bool SP2 = false>
__device__ __forceinline__ void gemm_phase(PG8_LAS unsigned char* lds, const Gemm g, const Sched& S, const Epi& E) {
    const int tid = threadIdx.x, wid = __builtin_amdgcn_readfirstlane(tid >> 6), lane = tid & 63, wr = wid >> 2, wc = wid & 3, fr = lane & 15, fq = lane >> 4;
    const int K = g.K, nt = K / BK;
    unsigned voffA[2], voffB[2];
#pragma unroll
    for (int i = 0; i < 2; ++i) { int R, C; stage_rc(tid * 16 + i * 8192, R, C); const int Rb = Epi::PERM ? ((R & ~31) + perm32(R & 31)) : R;
        voffA[i] = (unsigned)(R * K + C) * 2u; voffB[i] = (unsigned)(Rb * K + C) * 2u; }
    const size_t kstep = (size_t)(BK * 2);
    const size_t hstep = (size_t)HALF * K * 2;
    const size_t tstep = 2 * hstep;
    const unsigned ldsw = (unsigned)wid * 1024u;
    const int aoff = lds_byte(wr * 64 + fr, fq * 8), boff = lds_byte(wc * 32 + fr, fq * 8);
#define PG8_SA(b, h) (((b) * 2 + (h)) * HTB)
#define PG8_SB(b, h) ((4 + (b) * 2 + (h)) * HTB)
#define PG8_STAGE(bufoff, gbase, voff) do { _Pragma("unroll") for (int _i = 0; _i < 2; ++_i) \
        __builtin_amdgcn_global_load_lds((const unsigned*)((const char*)(gbase) + (voff)[_i]), (PG8_LAS unsigned*)(lds + (bufoff) + ldsw + _i * 8192), 16, 0, 0); } while (0)
#define PG8_LDA(dst, b, h) do { _Pragma("unroll") for (int m = 0; m < 4; ++m) _Pragma("unroll") for (int k = 0; k < 2; ++k) dst[m][k] = *(const PG8_LAS bf16x8*)(lds + PG8_SA(b, h) + aoff + m * 2048 + k * 1024); } while (0)
#define PG8_LDB(dst, b, h) do { _Pragma("unroll") for (int n = 0; n < 2; ++n) _Pragma("unroll") for (int k = 0; k < 2; ++k) dst[n][k] = *(const PG8_LAS bf16x8*)(lds + PG8_SB(b, h) + boff + n * 2048 + k * 1024); } while (0)
#define PG8_MMA(ai, bj, At, Bt) do { __builtin_amdgcn_s_setprio(1); _Pragma("unroll") for (int m = 0; m < 4; ++m) _Pragma("unroll") for (int n = 0; n < 2; ++n) _Pragma("unroll") for (int k = 0; k < 2; ++k) \
        acc[ai][bj][m][n] = __builtin_amdgcn_mfma_f32_16x16x32_bf16(Bt[n][k], At[m][k], acc[ai][bj][m][n], 0, 0, 0); __builtin_amdgcn_s_setprio(0); } while (0)
#define PG8_WAIT_V(n) asm volatile("s_waitcnt vmcnt(" #n ")" ::: "memory")
#define PG8_WAIT_L(n) asm volatile("s_waitcnt lgkmcnt(" #n ")" ::: "memory")
#define PG8_BAR __builtin_amdgcn_s_barrier()
#define PG8_SCHED __builtin_amdgcn_sched_barrier(0)
    Unit cur, nxt; int ui = 0;
    if (!S.next(0, cur)) return;
    f32x4 acc[2][2][4][2];
#pragma unroll
    for (int a = 0; a < 2; ++a)
#pragma unroll
        for (int b = 0; b < 2; ++b)
#pragma unroll
            for (int m = 0; m < 4; ++m)
#pragma unroll
                for (int n = 0; n < 2; ++n) acc[a][b][m][n] = (f32x4){0.f, 0.f, 0.f, 0.f};
    bf16x8 At[4][2], B0[2][2], B1[2][2];
    const char* cA = (const char*)g.A + (size_t)cur.pm * tstep; const char* cB = (const char*)g.Bt + (size_t)cur.pn * tstep;
    S.a_ready(cur);
    if constexpr (SP2) {
        PG8_STAGE(PG8_SB(0, 0), cB, voffB); PG8_STAGE(PG8_SB(0, 1), cB + hstep, voffB); PG8_STAGE(PG8_SA(0, 0), cA, voffA); PG8_STAGE(PG8_SA(0, 1), cA + hstep, voffA);
        if (wr == 1) PG8_BAR;
        PG8_WAIT_V(2); PG8_BAR;
        PG8_STAGE(PG8_SB(1, 0), cB + kstep, voffB); PG8_STAGE(PG8_SA(1, 0), cA + kstep, voffA); PG8_STAGE(PG8_SB(1, 1), cB + hstep + kstep, voffB);
        PG8_WAIT_V(6); PG8_BAR;
    } else {
        PG8_STAGE(PG8_SB(0, 0), cB, voffB); PG8_STAGE(PG8_SA(0, 0), cA, voffA); PG8_STAGE(PG8_SB(0, 1), cB + hstep, voffB); PG8_STAGE(PG8_SA(0, 1), cA + hstep, voffA);
        if (wr == 1) PG8_BAR;
        PG8_WAIT_V(4); PG8_BAR;
        PG8_STAGE(PG8_SB(1, 0), cB + kstep, voffB); PG8_STAGE(PG8_SA(1, 0), cA + kstep, voffA); PG8_STAGE(PG8_SB(1, 1), cB + hstep + kstep, voffB);
        PG8_WAIT_V(6); PG8_BAR;
    }
    for (;;) {
        const bool has_next = S.next(ui + 1, nxt);
        const char* nA = has_next ? (const char*)g.A + (size_t)nxt.pm * tstep : cA; const char* nB = has_next ? (const char*)g.Bt + (size_t)nxt.pn * tstep : cB;
        for (int t = 0; t < nt; t += 2) {
            const bool last = (t == nt - 2);
            const char* a1 = cA + (size_t)(t + 1) * kstep;
            const char* a2 = last ? nA : cA + (size_t)(t + 2) * kstep; const char* b2 = last ? nB : cB + (size_t)(t + 2) * kstep;
            const char* a3 = a2 + kstep; const char* b3 = b2 + kstep;
            if (last && has_next) S.a_ready(nxt);
            if constexpr (SP2) {
            PG8_LDB(B0, 0, 0); PG8_LDB(B1, 0, 1); PG8_SCHED; PG8_LDA(At, 0, 0); PG8_STAGE(PG8_SA(1, 1), a1 + hstep, voffA);
            PG8_WAIT_V(8); PG8_WAIT_L(0); PG8_BAR; PG8_MMA(0, 0, At, B0); PG8_MMA(0, 1, At, B1); PG8_BAR; PG8_SCHED;
            PG8_LDA(At, 0, 1); PG8_STAGE(PG8_SB(0, 0), b2, voffB); PG8_STAGE(PG8_SB(0, 1), b2 + hstep, voffB); PG8_STAGE(PG8_SA(0, 0), a2, voffA);
            PG8_WAIT_V(8); PG8_WAIT_L(0); PG8_BAR; PG8_MMA(1, 0, At, B0); PG8_MMA(1, 1, At, B1); PG8_BAR; PG8_SCHED;
            PG8_LDB(B0, 1, 0); PG8_LDB(B1, 1, 1); PG8_SCHED; PG8_LDA(At, 1, 0); PG8_STAGE(PG8_SA(0, 1), a2 + hstep, voffA);
            PG8_WAIT_V(8); PG8_WAIT_L(0); PG8_BAR; PG8_MMA(0, 0, At, B0); PG8_MMA(0, 1, At, B1); PG8_BAR; PG8_SCHED;
            PG8_LDA(At, 1, 1); PG8_STAGE(PG8_SB(1, 0), b3, voffB); PG8_STAGE(PG8_SB(1, 1), b3 + hstep, voffB); PG8_STAGE(PG8_SA(1, 0), a3, voffA);
            PG8_WAIT_V(8); PG8_WAIT_L(0); PG8_BAR; PG8_MMA(1, 0, At, B0); PG8_MMA(1, 1, At, B1); PG8_BAR; PG8_SCHED;
            } else {
            PG8_LDB(B0, 0, 0); PG8_SCHED; PG8_LDA(At, 0, 0); PG8_STAGE(PG8_SA(1, 1), a1 + hstep, voffA);
            PG8_WAIT_L(8); PG8_BAR; PG8_WAIT_L(0); PG8_MMA(0, 0, At, B0); PG8_BAR; PG8_SCHED;
            PG8_LDB(B1, 0, 1); PG8_STAGE(PG8_SB(0, 0), b2, voffB);
            PG8_BAR; PG8_WAIT_L(0); PG8_MMA(0, 1, At, B1); PG8_BAR;
            PG8_LDA(At, 0, 1); PG8_STAGE(PG8_SA(0, 0), a2, voffA);
            PG8_BAR; PG8_WAIT_L(0); PG8_MMA(1, 0, At, B0); PG8_BAR; PG8_SCHED;
            PG8_STAGE(PG8_SB(0, 1), b2 + hstep, voffB);
            PG8_WAIT_V(6); PG8_BAR; PG8_MMA(1, 1, At, B1); PG8_BAR;
            PG8_LDB(B0, 1, 0); PG8_SCHED; PG8_LDA(At, 1, 0); PG8_STAGE(PG8_SA(0, 1), a2 + hstep, voffA);
            PG8_WAIT_L(8); PG8_BAR; PG8_WAIT_L(0); PG8_MMA(0, 0, At, B0); PG8_BAR; PG8_SCHED;
            PG8_LDB(B1, 1, 1); PG8_STAGE(PG8_SB(1, 0), b3, voffB);
            PG8_BAR; PG8_WAIT_L(0); PG8_MMA(0, 1, At, B1); PG8_BAR;
            PG8_LDA(At, 1, 1); PG8_STAGE(PG8_SA(1, 0), a3, voffA);
            PG8_BAR; PG8_WAIT_L(0); PG8_MMA(1, 0, At, B0); PG8_BAR; PG8_SCHED;
            PG8_STAGE(PG8_SB(1, 1), b3 + hstep, voffB);
            PG8_WAIT_V(6); PG8_BAR; PG8_MMA(1, 1, At, B1); PG8_BAR;
            }
        }
        if constexpr (ALIGN_EPI) { if (wr == 0) PG8_BAR; }
        if constexpr (!Epi::AFTER_DRAIN) { E(acc, cur, wr, wc, fr, fq); S.done(cur); }
        if (!has_next) break;
#pragma unroll
        for (int a = 0; a < 2; ++a)
#pragma unroll
            for (int b = 0; b < 2; ++b)
#pragma unroll
                for (int m = 0; m < 4; ++m)
#pragma unroll
                    for (int n = 0; n < 2; ++n) acc[a][b][m][n] = (f32x4){0.f, 0.f, 0.f, 0.f};
        cur = nxt; cA = nA; cB = nB; ++ui;
        if constexpr (ALIGN_EPI) { if (wr == 1) PG8_BAR; }
    }
    PG8_WAIT_V(0);
    if constexpr (!ALIGN_EPI) { if (wr == 0) PG8_BAR; }
    PG8_BAR;
    if constexpr (Epi::AFTER_DRAIN) { E.fused(acc, cur, wr, wc, fr, fq, lds, wid, lane); S.done(cur); }
#undef PG8_SA
#undef PG8_SB
#undef PG8_STAGE
#undef PG8_LDA
#undef PG8_LDB
#undef PG8_MMA
#undef PG8_WAIT_V
#undef PG8_WAIT_L
#undef PG8_BAR
#undef PG8_SCHED
}
}
#define LAS __attribute__((address_space(3)))
#define DI __device__ __forceinline__
typedef unsigned short bf16;
typedef short bf16x8 __attribute__((ext_vector_type(8)));
typedef short s16x4 __attribute__((ext_vector_type(4)));
typedef float f32x4 __attribute__((ext_vector_type(4)));
typedef float f32x16 __attribute__((ext_vector_type(16)));
typedef unsigned u32x4 __attribute__((ext_vector_type(4)));
typedef unsigned u32x2 __attribute__((ext_vector_type(2)));
typedef float f32x2_t __attribute__((ext_vector_type(2)));
typedef __bf16 bf16x2_t __attribute__((ext_vector_type(2)));
DI unsigned pk2(float lo, float hi) { f32x2_t v = {lo, hi}; bf16x2_t b = __builtin_convertvector(v, bf16x2_t); return __builtin_bit_cast(unsigned, b); }
DI unsigned short f2bf(float x) { return (unsigned short)(pk2(x, 0.f) & 0xffffu); }
DI float bf2f(unsigned short u) { return __uint_as_float(((unsigned)u) << 16); }
using pg8::sigm;
DI int crow(int r, int hi) { return (r & 3) + 8 * (r >> 2) + 4 * hi; }
#define MFMA32(a, b, c) __builtin_amdgcn_mfma_f32_32x32x16_bf16((a), (b), (c), 0, 0, 0)
DI bf16x8 pack8(const f32x16& x, int s) {
    u32x4 p; p.x = pk2(x[8 * s], x[8 * s + 1]); p.y = pk2(x[8 * s + 2], x[8 * s + 3]); p.z = pk2(x[8 * s + 4], x[8 * s + 5]); p.w = pk2(x[8 * s + 6], x[8 * s + 7]);
    return __builtin_bit_cast(bf16x8, p);
}
DI bf16x8 join44(s16x4 a, s16x4 b) { return (bf16x8){a[0], a[1], a[2], a[3], b[0], b[1], b[2], b[3]}; }
DI float wave_sum(float v) {
#pragma unroll
    for (int o = 1; o < 64; o <<= 1) v += __shfl_xor(v, o);
    return v;
}

constexpr int NB = 4, SEQ = 8192, DM = 2048, CTX = 256, M = NB * SEQ, MC = NB * CTX;
constexpr int NIN = 12288, FFH = 5632, NMOD = 12288;
constexpr int U1W = 8192;
constexpr int C_HQ = 0, C_HFF = 1024, C_HOG = 3072, C_GA = 4096, C_GB = 6144;
constexpr int W_NOW = 6144;
constexpr int UC1W = 2048;
constexpr float EPS = 1e-6f;
constexpr float LOG2E = 1.4426950408889634f;
constexpr size_t MiB = 1u << 20;
constexpr size_t WS_MOD = 0, WS_PART = 1 * MiB, WS_WIN = 16 * MiB, WS_WPA = 64 * MiB, WS_WPB = 68 * MiB, WS_WOUT = 72 * MiB, WS_WF1 = 80 * MiB, WS_WF2 = 124 * MiB;
constexpr size_t WS_KHC = 146 * MiB, WS_UC1 = 148 * MiB, WS_VTC = 152 * MiB, WS_HC = 156 * MiB, WS_QKH = 160 * MiB, WS_U1 = 288 * MiB, WS_VT = 800 * MiB, WS_OB = 928 * MiB, WS_END = 992 * MiB;
constexpr size_t WS_YM = WS_VT, WS_H2 = WS_QKH, WS_HID = WS_U1;
constexpr size_t DO_H = 0, DO_ONA = 128 * MiB, DO_OF = 192 * MiB, DO_OHG = 0;
constexpr int LDS_BYTES = 147456;
constexpr size_t WS_BAR = 768 * 1024, BAR_BYTES = 16384;
constexpr int LDS_MISC = 131072;
constexpr int NPH = 12;
#ifndef MK_SPLIT
#define MK_SPLIT 0
#endif
constexpr bool USE_XCD_BAR = (MK_SPLIT == 0);
constexpr int GU_FILL = 176, GU_SPLIT2 = GU_FILL + 8 * 192;
constexpr int GU_SPLIT = 1728;

__device__ const int kInRowMap[12] = {1024, 2048, 10240, 0, 3072, 4096, 11264, 5120, 6144, 7168, 8192, 9216};

struct Args { const float* in[18]; float* out; unsigned char* ws; int ph_lo, ph_hi; };

DI void transpose_item(const float* W, int K, int N, bf16* WT, int k0, int n0, int drow0, LAS float* scr, int lane) {
#pragma unroll 8
    for (int i = 0; i < 32; ++i) { const int kk = 2 * i + (lane >> 5); scr[kk * 33 + (lane & 31)] = __builtin_nontemporal_load(W + (size_t)(k0 + kk) * N + n0 + (lane & 31)); }
    asm volatile("s_waitcnt lgkmcnt(0)" ::: "memory");
    const int c = lane & 7;
#pragma unroll
    for (int j = 0; j < 4; ++j) { const int n = (lane >> 3) + 8 * j; const LAS float* s = scr + (8 * c) * 33 + n;
        u32x4 o; o.x = pk2(s[0 * 33], s[1 * 33]); o.y = pk2(s[2 * 33], s[3 * 33]); o.z = pk2(s[4 * 33], s[5 * 33]); o.w = pk2(s[6 * 33], s[7 * 33]);
        *(u32x4*)(WT + (size_t)(drow0 + n) * K + k0 + 8 * c) = o; }
    asm volatile("s_waitcnt lgkmcnt(0)" ::: "memory");
}

DI void norm_row(const float* xrow, const float* g, const float* sc, const float* sh, bf16* obf, float* of32, int lane) {
    const f32x4* xr = (const f32x4*)xrow + lane;
    f32x4 v[8]; float s = 0.f;
#pragma unroll
    for (int j = 0; j < 8; ++j) { v[j] = xr[64 * j]; s += (v[j].x * v[j].x + v[j].y * v[j].y) + (v[j].z * v[j].z + v[j].w * v[j].w); }
    const float rstd = 1.0f / sqrtf(wave_sum(s) * (1.0f / DM) + EPS);
#pragma unroll
    for (int j = 0; j < 8; ++j) {
        const int c4 = lane + 64 * j;
        f32x4 y = v[j] * rstd * ((const f32x4*)g)[c4];
        if (sc) y = y * (((const f32x4*)sc)[c4] + 1.0f) + ((const f32x4*)sh)[c4];
        if (obf) { u32x2 o; o.x = pk2(y.x, y.y); o.y = pk2(y.z, y.w); ((u32x2*)obf)[c4] = o; }
        else ((f32x4*)of32)[c4] = y;
    }
}

template <bool NT_LD, bool NT_ST> DI void norm_row2(const float* xrow0, const float* xrow1, const float* g, const float* sc, const float* sh, bf16* obf0, bf16* obf1, float* of0, float* of1, int lane) {
    const f32x4* xr0 = (const f32x4*)xrow0 + lane; const f32x4* xr1 = (const f32x4*)xrow1 + lane;
    f32x4 v0[8], v1[8]; float s0 = 0.f, s1 = 0.f;
#pragma unroll
    for (int j = 0; j < 8; ++j) { if (NT_LD) { v0[j] = __builtin_nontemporal_load(xr0 + 64 * j); v1[j] = __builtin_nontemporal_load(xr1 + 64 * j); } else { v0[j] = xr0[64 * j]; v1[j] = xr1[64 * j]; } }
#pragma unroll
    for (int j = 0; j < 8; ++j) { s0 += (v0[j].x * v0[j].x + v0[j].y * v0[j].y) + (v0[j].z * v0[j].z + v0[j].w * v0[j].w); s1 += (v1[j].x * v1[j].x + v1[j].y * v1[j].y) + (v1[j].z * v1[j].z + v1[j].w * v1[j].w); }
#pragma unroll
    for (int o = 1; o < 64; o <<= 1) { s0 += __shfl_xor(s0, o); s1 += __shfl_xor(s1, o); }
    const float r0 = 1.0f / sqrtf(s0 * (1.0f / DM) + EPS), r1 = 1.0f / sqrtf(s1 * (1.0f / DM) + EPS);
#pragma unroll
    for (int j = 0; j < 8; ++j) {
        const int c4 = lane + 64 * j;
        const f32x4 gg = ((const f32x4*)g)[c4];
        f32x4 y0 = v0[j] * r0 * gg, y1 = v1[j] * r1 * gg;
        if (sc) { const f32x4 a = ((const f32x4*)sc)[c4] + 1.0f, bsh = ((const f32x4*)sh)[c4]; y0 = y0 * a + bsh; y1 = y1 * a + bsh; }
        if (obf0) { u32x2 o0; o0.x = pk2(y0.x, y0.y); o0.y = pk2(y0.z, y0.w); ((u32x2*)obf0)[c4] = o0; u32x2 o1; o1.x = pk2(y1.x, y1.y); o1.y = pk2(y1.z, y1.w); ((u32x2*)obf1)[c4] = o1; }
        else if (NT_ST) { __builtin_nontemporal_store(y0, (f32x4*)of0 + c4); __builtin_nontemporal_store(y1, (f32x4*)of1 + c4); }
        else { ((f32x4*)of0)[c4] = y0; ((f32x4*)of1)[c4] = y1; }
    }
}

DI float max3f(float a, float b, float c) { float r; asm("v_max3_f32 %0, %1, %2, %3" : "=v"(r) : "v"(a), "v"(b), "v"(c)); return r; }
constexpr float NA_RESCALE_THR = 6.0f;
constexpr int RPB_OFF = 64;
constexpr int RPB_NINF = RPB_OFF + 16 * 15 * 31 + 128;
constexpr int RPB_FLOATS = RPB_NINF + 64;
DI void na_load_k(int blk, int b, int rs0, int kc0, int h, int l32, int hi, const bf16* QKH, const bf16* KHC, bf16x8 (&kf)[4]) {
    const bf16* kp;
    if (blk < 8) { const int tok = b * CTX + 32 * blk; kp = KHC + ((size_t)h * MC + tok + l32) * 64 + 8 * hi; }
    else { const int tok = b * SEQ + (rs0 + blk - 8) * 64 + kc0; kp = QKH + ((size_t)(16 + h) * M + tok + l32) * 64 + 8 * hi; }
#pragma unroll
    for (int s = 0; s < 4; ++s) kf[s] = *(const bf16x8*)(kp + 16 * s);
}
DI void na_load_v(int blk, int b, int rs0, int kc0, int h, int l32, int hi, const bf16* VT, const bf16* VTC, bf16x8 (&vf)[2][2]) {
    const bf16* vb; int t0;
    if (blk < 8) { vb = VTC; t0 = b * CTX + 32 * blk + 4 * hi; }
    else { vb = VT; t0 = b * SEQ + (rs0 + blk - 8) * 64 + kc0 + 4 * hi; }
    const bf16* vp = vb + (size_t)(h * 64 + l32) * 32;
#pragma unroll
    for (int d = 0; d < 2; ++d)
#pragma unroll
        for (int s = 0; s < 2; ++s) { const int ta = t0 + 16 * s, tb = ta + 8;
            vf[d][s] = join44(*(const s16x4*)(vp + (size_t)(ta >> 5) * 65536 + (size_t)(32 * d) * 32 + (ta & 31)), *(const s16x4*)(vp + (size_t)(tb >> 5) * 65536 + (size_t)(32 * d) * 32 + (tb & 31))); }
}
struct NaState { f32x16 o0, o1; float mrun, lrun; };
template <bool BAND> DI void na_block(NaState& st_, const bf16x8 (&kf)[4], const bf16x8 (&vf)[2][2], const bf16x8 (&qf)[4], const LAS float* rp, const LAS float* madd) {
    const float C1 = 0.125f * LOG2E;
    f32x16 st;
#pragma unroll
    for (int i = 0; i < 16; ++i) st[i] = 0.f;
#pragma unroll
    for (int s = 0; s < 4; ++s) st = MFMA32(kf[s], qf[s], st);
    if (BAND) {
#pragma unroll
        for (int i = 0; i < 16; ++i) { const float bb = rp[(i & 3) + 8 * (i >> 2)] + madd[i * 64]; st[i] = __builtin_fmaf(st[i], C1, bb); }
    } else {
#pragma unroll
        for (int i = 0; i < 16; ++i) st[i] *= C1;
    }
    float mx = max3f(st[0], st[1], st[2]);
#pragma unroll
    for (int i = 3; i < 15; i += 2) mx = max3f(mx, st[i], st[i + 1]);
    mx = fmaxf(mx, st[15]);
    { const auto rr = __builtin_amdgcn_permlane32_swap(__float_as_uint(mx), __float_as_uint(mx), false, false); mx = fmaxf(__uint_as_float(rr[0]), __uint_as_float(rr[1])); }
    if (__any(mx > st_.mrun + NA_RESCALE_THR)) {
        const float mnew = fmaxf(st_.mrun, mx);
        const float alpha = __builtin_amdgcn_exp2f(st_.mrun - mnew);
        st_.mrun = mnew; st_.lrun *= alpha;
#pragma unroll
        for (int i = 0; i < 16; ++i) { st_.o0[i] *= alpha; st_.o1[i] *= alpha; }
    }
    float ps = 0.f; const float mm = st_.mrun;
#pragma unroll
    for (int i = 0; i < 16; ++i) { st[i] = __builtin_amdgcn_exp2f(st[i] - mm); ps += st[i]; }
    st_.lrun += ps;
    const bf16x8 p0 = pack8(st, 0), p1 = pack8(st, 1);
    st_.o0 = MFMA32(vf[0][0], p0, st_.o0); st_.o0 = MFMA32(vf[0][1], p1, st_.o0);
    st_.o1 = MFMA32(vf[1][0], p0, st_.o1); st_.o1 = MFMA32(vf[1][1], p1, st_.o1);
}
DI void na_task(int task, const bf16* QKH, const bf16* KHC, const bf16* VT, const bf16* VTC, bf16* ONA, const LAS float* rpb, LAS float* mtab, int lane) {
    const int cq = task & 3, h = (task >> 2) & 15, rpair = (task >> 6) & 63, b = task >> 12;
    const int l32 = lane & 31, hi = lane >> 5;
    const int r = 2 * rpair + (l32 >> 4), qc = 16 * cq + (l32 & 15);
    const int rs = min(max(r - 4, 0), 120);
    const int rs0 = min(max(2 * rpair - 4, 0), 120), rs1 = min(max(2 * rpair - 3, 0), 120);
    const int nb = 8 + (rs1 + 8 - rs0);
    const int kc0 = (cq == 0) ? 0 : (cq == 1) ? 8 : (cq == 2) ? 24 : 32;
    const int cs = min(max(qc - 8, 0), 48);
    const bf16* qp = QKH + ((size_t)h * M + b * SEQ + r * 64 + qc) * 64 + 8 * hi;
    bf16x8 qf[4];
#pragma unroll
    for (int s = 0; s < 4; ++s) qf[s] = *(const bf16x8*)(qp + 16 * s);
    LAS float* madd = mtab + lane;
#pragma unroll
    for (int i = 0; i < 16; ++i) { const int kc = kc0 + crow(i, hi); madd[i * 64] = (kc >= cs && kc < cs + 16) ? 0.f : -INFINITY; }
    NaState S;
#pragma unroll
    for (int i = 0; i < 16; ++i) { S.o0[i] = 0.f; S.o1[i] = 0.f; }
    S.mrun = -INFINITY; S.lrun = 0.f;
    const LAS float* rpq = rpb + RPB_OFF + (h * 15 + 7 - r) * 31 + (15 - qc + kc0 + 4 * hi);
    const LAS float* rpn = rpb + RPB_NINF + 4 * hi;
    bf16x8 kfn[4], vf[2][2];
    na_load_k(0, b, rs0, kc0, h, l32, hi, QKH, KHC, kfn);
    for (int blk = 0; blk < nb; ++blk) {
        bf16x8 kf[4];
#pragma unroll
        for (int s = 0; s < 4; ++s) kf[s] = kfn[s];
        na_load_v(blk, b, rs0, kc0, h, l32, hi, VT, VTC, vf);
        if (blk + 1 < nb) na_load_k(blk + 1, b, rs0, kc0, h, l32, hi, QKH, KHC, kfn);
        if (blk < 8) na_block<false>(S, kf, vf, qf, rpq, madd);
        else { const int krow = rs0 + blk - 8; const bool rv = (krow >= rs) && (krow < rs + 8);
            na_block<true>(S, kf, vf, qf, rv ? rpq + krow * 31 : rpn, madd); }
    }
    float lrun = S.lrun; lrun += __shfl_xor(lrun, 32);
    const float inv = 1.0f / lrun;
    bf16* op = ONA + (size_t)(b * SEQ + r * 64 + qc) * 1024 + h * 64 + 4 * hi;
#pragma unroll
    for (int g = 0; g < 4; ++g) {
        u32x2 w0; w0.x = pk2(S.o0[4 * g] * inv, S.o0[4 * g + 1] * inv); w0.y = pk2(S.o0[4 * g + 2] * inv, S.o0[4 * g + 3] * inv); *(u32x2*)(op + 8 * g) = w0;
        u32x2 w1; w1.x = pk2(S.o1[4 * g] * inv, S.o1[4 * g + 1] * inv); w1.y = pk2(S.o1[4 * g + 2] * inv, S.o1[4 * g + 3] * inv); *(u32x2*)(op + 32 + 8 * g) = w1;
    }
}

constexpr int HP = 136;
constexpr int HKP = 40;
constexpr int H_AT = 0, H_QP = 32 * HP * 2, H_KT = 2 * 32 * HP * 2, H_KTT = 3 * 32 * HP * 2, H_DV = H_KTT + 128 * HKP * 2, H_BUF = H_DV + 512;
constexpr int H_GT = 2 * H_BUF;
struct HgGate { int dir, tqs, kp; const bf16* x1u; const bf16* x0u; const bf16* q1u; LAS float* GT; LAS unsigned char* lds; };
#define HG_T0D(g, dir) (((g) >= 8) ? ((dir) ? SEQ - 32 - 32 * ((g) - 8) : 32 * ((g) - 8)) : ((dir) ? CTX - 32 - 32 * (g) : 32 * (g)))
DI void hg_load_gate(const HgGate& c, int g, unsigned (&xo_)[8], unsigned (&q_)[8]) {
    const int sg_ = g >= 8; const int r0_ = HG_T0D(g, c.dir) + 8 * c.tqs; const bf16* xb_ = sg_ ? c.x1u : c.x0u; const size_t xp_ = sg_ ? U1W : UC1W;
#pragma unroll
    for (int i = 0; i < 8; ++i) { xo_[i] = ((const unsigned*)(xb_ + (size_t)(r0_ + i) * xp_))[c.kp]; q_[i] = ((const unsigned*)(c.q1u + (size_t)(r0_ + i) * U1W))[c.kp]; }
}
DI void hg_sums(const HgGate& c, int par, const unsigned (&xo_)[8]) {
    float a0_ = 0.f, a1_ = 0.f;
#pragma unroll
    for (int i = 0; i < 8; ++i) { a0_ += pg8::bflo(xo_[i]); a1_ += pg8::bfhi(xo_[i]); }
    *(LAS f32x2_t*)(c.GT + ((par & 1) * 4 + c.tqs) * 128 + 2 * c.kp) = (f32x2_t){a0_, a1_};
}
template <int NC> DI void hg_gate_tick(const HgGate& c, int t, const unsigned (&xo_c)[8], const unsigned (&q_c)[8], const unsigned (&xo_n)[8], unsigned (&xo_p)[8], unsigned (&q_p)[8]) {
    const int dir = c.dir, tqs = c.tqs, kp = c.kp;
    hg_load_gate(c, (t + 2 < NC) ? t + 2 : NC - 1, xo_p, q_p);
    hg_sums(c, t + 1, xo_n);
    {
        const int seg = t >= 8;
        LAS unsigned char* buf = c.lds + (t & 1) * H_BUF;
        const LAS float* gt = c.GT + (t & 1) * 512 + 2 * kp;
        const f32x2_t g0 = *(const LAS f32x2_t*)gt, g1 = *(const LAS f32x2_t*)(gt + 128), g2 = *(const LAS f32x2_t*)(gt + 256), g3 = *(const LAS f32x2_t*)(gt + 384);
        const float tot0 = (g0.x + g1.x) + (g2.x + g3.x), tot1 = (g0.y + g1.y) + (g2.y + g3.y);
        float of0, of1;
        if (!dir) { of0 = (tqs > 0 ? g0.x : 0.f) + (tqs > 1 ? g1.x : 0.f) + (tqs > 2 ? g2.x : 0.f); of1 = (tqs > 0 ? g0.y : 0.f) + (tqs > 1 ? g1.y : 0.f) + (tqs > 2 ? g2.y : 0.f); }
        else { of0 = (tqs < 3 ? g3.x : 0.f) + (tqs < 2 ? g2.x : 0.f) + (tqs < 1 ? g1.x : 0.f); of1 = (tqs < 3 ? g3.y : 0.f) + (tqs < 2 ? g2.y : 0.f) + (tqs < 1 ? g1.y : 0.f); }
        float c0[8], c1[8];
        if (!dir) { float a0 = of0, a1 = of1;
#pragma unroll
            for (int i = 0; i < 8; ++i) { a0 += pg8::bflo(xo_c[i]); a1 += pg8::bfhi(xo_c[i]); c0[i] = a0; c1[i] = a1; } }
        else { float a0 = of0, a1 = of1;
#pragma unroll
            for (int i = 7; i >= 0; --i) { a0 += pg8::bflo(xo_c[i]); a1 += pg8::bfhi(xo_c[i]); c0[i] = a0; c1[i] = a1; } }
        LAS unsigned* Qp = (LAS unsigned*)(buf + H_QP); LAS unsigned* Kt = (LAS unsigned*)(buf + H_KT); LAS bf16* KtT = (LAS bf16*)(buf + H_KTT); LAS float* dv = (LAS float*)(buf + H_DV);
        const float d0 = __builtin_amdgcn_exp2f(tot0), d1 = __builtin_amdgcn_exp2f(tot1);
        float k0v[8], k1v[8], r0[8], r1[8];
        const float ri0 = __builtin_amdgcn_rcpf(__builtin_amdgcn_exp2f(fmaxf(of0, -100.f))), ri1 = __builtin_amdgcn_rcpf(__builtin_amdgcn_exp2f(fmaxf(of1, -100.f)));
#pragma unroll
        for (int i = 0; i < 8; ++i) { const int j = 8 * tqs + i;
            const float e0 = __builtin_amdgcn_exp2f(fmaxf(c0[i], -100.f)), e1 = __builtin_amdgcn_exp2f(fmaxf(c1[i], -100.f));
            r0[i] = __builtin_amdgcn_rcpf(e0); r1[i] = __builtin_amdgcn_rcpf(e1);
            if (seg) Qp[j * (HP / 2) + kp] = pk2(pg8::bflo(q_c[i]) * e0, pg8::bfhi(q_c[i]) * e1); }
#pragma unroll
        for (int i = 0; i < 8; ++i) { const int j = 8 * tqs + i;
            const float p0 = dir ? (i < 7 ? r0[i < 7 ? i + 1 : 7] : ri0) : (i > 0 ? r0[i > 0 ? i - 1 : 0] : ri0), p1 = dir ? (i < 7 ? r1[i < 7 ? i + 1 : 7] : ri1) : (i > 0 ? r1[i > 0 ? i - 1 : 0] : ri1);
            k0v[i] = r0[i] - p0; k1v[i] = r1[i] - p1;
            Kt[j * (HP / 2) + kp] = pk2(k0v[i], k1v[i]); }
        { u32x4 w; w.x = pk2(k0v[0], k0v[1]); w.y = pk2(k0v[2], k0v[3]); w.z = pk2(k0v[4], k0v[5]); w.w = pk2(k0v[6], k0v[7]); *(LAS u32x4*)(KtT + (2 * kp) * HKP + 8 * tqs) = w; }
        { u32x4 w; w.x = pk2(k1v[0], k1v[1]); w.y = pk2(k1v[2], k1v[3]); w.z = pk2(k1v[4], k1v[5]); w.w = pk2(k1v[6], k1v[7]); *(LAS u32x4*)(KtT + (2 * kp + 1) * HKP + 8 * tqs) = w; }
        if (tqs == 0) { dv[2 * kp] = d0; dv[2 * kp + 1] = d1; }
    }
    asm volatile("s_waitcnt lgkmcnt(0)\n\ts_barrier" ::: "memory");
}
DI void hgrn_item(int item, const float* lbl, const bf16* U1, const bf16* UC1, const bf16* VT, const bf16* VTC, bf16* OF, bf16* OB, LAS unsigned char* lds) {
    const int b = item >> 4, h = (item >> 1) & 7, dir = item & 1;
    const int tid = threadIdx.x, lane = tid & 63, wave = __builtin_amdgcn_readfirstlane(tid >> 6), l32 = lane & 31, hi = lane >> 5;
    const bool gate_role = wave >= 4;
    const int kp = tid & 63, tq = (tid >> 6) & 3;
    bf16* OD = dir ? OB : OF;
    constexpr int NC = CTX / 32 + SEQ / 32;
    const bf16* x1 = U1 + (size_t)(b * SEQ) * U1W + C_HFF + dir * 1024 + h * 128 + 2 * kp;
    const bf16* x0 = UC1 + (size_t)(b * CTX) * UC1W + dir * 1024 + h * 128 + 2 * kp;
    const bf16* q1 = U1 + (size_t)(b * SEQ) * U1W + C_HQ + h * 128 + 2 * kp;
    const bf16* v1 = VT + (size_t)((b * SEQ) >> 5) * 65536 + (size_t)(1024 + h * 128 + 32 * (wave & 3) + l32) * 32 + 4 * hi;
    const bf16* v0 = VTC + (size_t)((b * CTX) >> 5) * 65536 + (size_t)(1024 + h * 128 + 32 * (wave & 3) + l32) * 32 + 4 * hi;
    f32x16 S[4];
#pragma unroll
    for (int a = 0; a < 4; ++a)
#pragma unroll
        for (int i = 0; i < 16; ++i) S[a][i] = 0.f;
    unsigned xo_c[8], q_c[8], xo_n[8], q_n[8], xo_p[8], q_p[8]; s16x4 vn[4];
    const int tqs = wave & 3;
    const bf16* x1u = U1 + (size_t)(b * SEQ) * U1W + C_HFF + dir * 1024 + h * 128;
    const bf16* x0u = UC1 + (size_t)(b * CTX) * UC1W + dir * 1024 + h * 128;
    const bf16* q1u = U1 + (size_t)(b * SEQ) * U1W + C_HQ + h * 128;
    LAS float* GT = (LAS float*)(lds + H_GT);
#define HG_T0(g) (((g) >= 8) ? (dir ? SEQ - 32 - 32 * ((g) - 8) : 32 * ((g) - 8)) : (dir ? CTX - 32 - 32 * (g) : 32 * (g)))
#define HG_LOAD_GATE(g, xo_, q_) do { const int sg_ = (g) >= 8; const int r0_ = HG_T0(g) + 8 * tqs; const bf16* xb_ = sg_ ? x1u : x0u; const size_t xp_ = sg_ ? U1W : UC1W; \
        _Pragma("unroll") for (int i = 0; i < 8; ++i) { xo_[i] = ((const unsigned*)(xb_ + (size_t)(r0_ + i) * xp_))[kp]; q_[i] = sg_ ? ((const unsigned*)(q1u + (size_t)(r0_ + i) * U1W))[kp] : 0u; } } while (0)
#define HG_SUMS(g, xo_) do { float a0_ = 0.f, a1_ = 0.f; _Pragma("unroll") for (int i = 0; i < 8; ++i) { a0_ += pg8::bflo(xo_[i]); a1_ += pg8::bfhi(xo_[i]); } \
        *(LAS f32x2_t*)(GT + (((g) & 1) * 4 + tqs) * 128 + 2 * kp) = (f32x2_t){a0_, a1_}; } while (0)
#define HG_LOAD_V(g) do { const int t0_ = HG_T0(g); const bf16* vb_ = ((g) >= 8) ? v1 : v0; \
        _Pragma("unroll") for (int s = 0; s < 4; ++s) vn[s] = *(const s16x4*)(vb_ + (size_t)(t0_ >> 5) * 65536 + 8 * s); } while (0)
    if (gate_role) {
        const HgGate gc{dir, tqs, kp, x1u, x0u, q1u, GT, lds};
        hg_load_gate(gc, 0, xo_c, q_c); hg_load_gate(gc, 1, xo_n, q_n);
        hg_sums(gc, 0, xo_c);
        asm volatile("s_waitcnt lgkmcnt(0)\n\ts_barrier" ::: "memory");
        static_assert(NC % 3 == 0, "three ticks per trip");
        for (int t = 0; t < NC; t += 3) {
            hg_gate_tick<NC>(gc, t, xo_c, q_c, xo_n, xo_p, q_p);
            hg_gate_tick<NC>(gc, t + 1, xo_n, q_n, xo_p, xo_c, q_c);
            hg_gate_tick<NC>(gc, t + 2, xo_p, q_p, xo_c, xo_n, q_n);
        }
        asm volatile("s_waitcnt lgkmcnt(0)\n\ts_barrier" ::: "memory");
    } else {
        HG_LOAD_V(0);
        unsigned ob[16]; int ob_t0 = 0; bool have_ob = false;
#pragma unroll
        for (int i = 0; i < 16; ++i) ob[i] = 0u;
        asm volatile("s_waitcnt lgkmcnt(0)\n\ts_barrier" ::: "memory");
        for (int t = 0; t <= NC; ++t) {
            if (t >= 1) {
                const int g = t - 1, seg = g >= 8, t0 = HG_T0(g);
                LAS unsigned char* buf = lds + (g & 1) * H_BUF;
                LAS bf16* At = (LAS bf16*)(buf + H_AT); LAS bf16* Qp = (LAS bf16*)(buf + H_QP); LAS bf16* Kt = (LAS bf16*)(buf + H_KT); LAS bf16* KtT = (LAS bf16*)(buf + H_KTT); LAS float* dv = (LAS float*)(buf + H_DV);
                bf16x8 vf0 = join44(vn[0], vn[1]), vf1 = join44(vn[2], vn[3]);
                asm volatile("" : "+v"(vf0), "+v"(vf1));
                if (t < NC) HG_LOAD_V(t);
                if (have_ob) {
                    bf16* op = OD + (size_t)(b * SEQ + ob_t0) * 1024 + h * 128 + 32 * wave + l32;
#pragma unroll
                    for (int i = 0; i < 16; ++i) op[(size_t)crow(i, hi) * 1024] = (bf16)ob[i];
                    have_ob = false;
                }
                const LAS bf16* kp_ = Kt + l32 * HP + 8 * hi; const LAS bf16* ap_ = Qp + l32 * HP + 8 * hi;     const LAS bf16* qp_ = Qp + l32 * HP + 4 * hi; const LAS bf16* tp_ = KtT + l32 * HKP + 4 * hi;
#define HG_RD(s8, kf_, af_, qf_, tf_) do { tf_ = join44(*(const LAS s16x4*)(tp_ + 32 * ((s8) >> 1) * HKP + 16 * ((s8) & 1)), *(const LAS s16x4*)(tp_ + 32 * ((s8) >> 1) * HKP + 16 * ((s8) & 1) + 8)); \
        if (seg) { kf_ = *(const LAS bf16x8*)(kp_ + 16 * (s8)); af_ = *(const LAS bf16x8*)(ap_ + 16 * (s8)); qf_ = join44(*(const LAS s16x4*)(qp_ + 16 * (s8)), *(const LAS s16x4*)(qp_ + 16 * (s8) + 8)); } } while (0)
                f32x16 pT, o;
#pragma unroll
                for (int i = 0; i < 16; ++i) { pT[i] = 0.f; o[i] = 0.f; }
                bf16x8 kA = vf0, aA = vf0, qA = vf0, tA = vf0, kB = vf0, aB = vf0, qB = vf0, tB = vf0;
                HG_RD(0, kA, aA, qA, tA);
#pragma unroll
                for (int kt = 0; kt < 4; ++kt) {
                    bf16x8 so0 = vf0, so1 = vf0;
                    if (seg) { so0 = pack8(S[kt], 0); so1 = pack8(S[kt], 1); }
                    HG_RD(2 * kt + 1, kB, aB, qB, tB);
                    if (seg) { pT = MFMA32(kA, aA, pT); o = MFMA32(qA, so0, o); }
                    S[kt] = MFMA32(tA, vf0, S[kt]);
                    if (kt < 3) HG_RD(2 * kt + 2, kA, aA, qA, tA);
                    if (seg) { pT = MFMA32(kB, aB, pT); o = MFMA32(qB, so1, o); }
                    S[kt] = MFMA32(tB, vf1, S[kt]);
                    if (kt > 0) {
#pragma unroll
                        for (int gq = 0; gq < 4; ++gq) { const f32x4 d4 = *(const LAS f32x4*)(dv + 32 * (kt - 1) + 8 * gq + 4 * hi);
                            S[kt - 1][4 * gq] *= d4.x; S[kt - 1][4 * gq + 1] *= d4.y; S[kt - 1][4 * gq + 2] *= d4.z; S[kt - 1][4 * gq + 3] *= d4.w; } }
                }
#undef HG_RD
                if (seg) {
#pragma unroll
                    for (int i = 0; i < 16; ++i) { const int si = crow(i, hi); const bool keep = dir ? (si >= l32) : (si <= l32); pT[i] = keep ? pT[i] : 0.f; }
                    const bf16x8 pf0 = pack8(pT, 0), pf1 = pack8(pT, 1);
                    o = MFMA32(pf0, vf0, o); o = MFMA32(pf1, vf1, o);
#pragma unroll
                    for (int i = 0; i < 16; ++i) ob[i] = f2bf(o[i]);
                    ob_t0 = t0; have_ob = true;
                }
#pragma unroll
                for (int gq = 0; gq < 4; ++gq) { const f32x4 d4 = *(const LAS f32x4*)(dv + 96 + 8 * gq + 4 * hi);
                    S[3][4 * gq] *= d4.x; S[3][4 * gq + 1] *= d4.y; S[3][4 * gq + 2] *= d4.z; S[3][4 * gq + 3] *= d4.w; }
            }
            asm volatile("s_waitcnt lgkmcnt(0)\n\ts_barrier" ::: "memory");
        }
        if (have_ob) { bf16* op = OD + (size_t)(b * SEQ + ob_t0) * 1024 + h * 128 + 32 * wave + l32;
#pragma unroll
            for (int i = 0; i < 16; ++i) op[(size_t)crow(i, hi) * 1024] = (bf16)ob[i]; }
    }
#undef HG_T0
#undef HG_LOAD_GATE
#undef HG_SUMS
#undef HG_LOAD_V
}

#define RLX_AGENT __ATOMIC_RELAXED, __HIP_MEMORY_SCOPE_AGENT
#define XB_TMO      128
#define XB_XCNT(j)  (256  + 64 * (j))
#define XB_XSUB(j)  (1280 + 64 * (j))
#define XB_XGEN(j)  (2304 + 64 * (j))
#define XB_TOP      3328
#define XB_TOPGEN   3392
#define XCD_BAR_WORDS 3456
#define XB_SPIN_CAP (1u << 18)

__device__ __forceinline__ unsigned xb_ld(unsigned* p)              { return __hip_atomic_load(p, __ATOMIC_RELAXED, __HIP_MEMORY_SCOPE_AGENT); }
__device__ __forceinline__ unsigned xb_add(unsigned* p, unsigned v) { return __hip_atomic_fetch_add(p, v, __ATOMIC_RELAXED, __HIP_MEMORY_SCOPE_AGENT); }
__device__ __forceinline__ unsigned xb_xcc_id() { return (unsigned)__builtin_amdgcn_s_getreg((3 << 11) | 20) & 0xFu; }
#define XB_SPIN(cond, bar) do { unsigned _sp = 0; while (cond) { __builtin_amdgcn_s_sleep(1); \
    if ((++_sp & 255u) == 0u) { if (xb_ld(&(bar)[XB_TMO])) break; if (_sp > XB_SPIN_CAP) { atomicAdd(&(bar)[XB_TMO], 1u); break; } } } } while (0)

struct XcdBarrier {
    unsigned* bar; unsigned x;
    volatile LAS unsigned* st;
};

__device__ __forceinline__ XcdBarrier xcd_barrier_post(unsigned* bar, volatile LAS unsigned* st) {
    XcdBarrier b; b.bar = bar; b.x = xb_xcc_id(); b.st = st;
    if (threadIdx.x == 0) (void)xb_add(&bar[XB_XCNT(b.x)], 1u);
    return b;
}
__device__ __forceinline__ void xcd_barrier_complete(unsigned* bar, unsigned x, unsigned& nloc, unsigned& nx) {
    const unsigned G = gridDim.x * gridDim.y * gridDim.z;
    unsigned sum, cnt, mine, sp = 0u;
    for (;;) {
        sum = 0u; cnt = 0u; mine = 0u;
#pragma unroll
        for (unsigned j = 0; j < 16; ++j) { const unsigned c = xb_ld(&bar[XB_XCNT(j)]); sum += c; cnt += (c > 0u) ? 1u : 0u; mine = (j == x) ? c : mine; }
        if (sum == G) break;
        __builtin_amdgcn_s_sleep(1);
        if ((++sp & 255u) == 0u) { if (xb_ld(&bar[XB_TMO])) break; if (sp > XB_SPIN_CAP) { atomicAdd(&bar[XB_TMO], 1u); break; } }
    }
    nloc = mine > 0u ? mine : 1u; nx = cnt > 0u ? cnt : 1u;
}

__device__ __forceinline__ void xcd_barrier(const XcdBarrier& b) {
    asm volatile("s_waitcnt vmcnt(0)" ::: "memory");
    __syncthreads();
    if (threadIdx.x == 0) {
        unsigned* bar = b.bar;
        __builtin_amdgcn_s_waitcnt(0);
        unsigned nloc = b.st[0], nx = b.st[1];
        if (nloc == 0u) { xcd_barrier_complete(bar, b.x, nloc, nx); b.st[0] = nloc; b.st[1] = nx; }
        const unsigned old = xb_add(&bar[XB_XSUB(b.x)], 1u);
        const unsigned gen = old / nloc;
        if (old + 1u == (gen + 1u) * nloc) {
            __builtin_amdgcn_fence(__ATOMIC_RELEASE, "agent");
            asm volatile("s_waitcnt vmcnt(0)" ::: "memory");
            const unsigned og = xb_add(&bar[XB_TOP], 1u);
            const unsigned tg = og / nx;
            if (og + 1u == (tg + 1u) * nx) xb_add(&bar[XB_TOPGEN], 1u);
            else XB_SPIN(xb_ld(&bar[XB_TOPGEN]) == tg, bar);
            __builtin_amdgcn_fence(__ATOMIC_ACQUIRE, "agent");
            xb_add(&bar[XB_XGEN(b.x)], 1u);
            asm volatile("s_waitcnt vmcnt(0)" ::: "memory");
        } else {
            XB_SPIN(xb_ld(&bar[XB_XGEN(b.x)]) == gen, bar);
            __builtin_amdgcn_fence(__ATOMIC_ACQUIRE, "agent");
            asm volatile("s_waitcnt vmcnt(0)" ::: "memory");
        }
    }
    __syncthreads();
}

__global__ void __launch_bounds__(512, 2) fwd_mega(Args args) {
    extern __shared__ __attribute__((aligned(16))) unsigned char lds_raw[];
    LAS unsigned char* lds = (LAS unsigned char*)lds_raw;
    cg::grid_group grid = cg::this_grid();
    const int tid = threadIdx.x, lane_k = tid & 63, wave = __builtin_amdgcn_readfirstlane(tid >> 6);
    const int G = gridDim.x, bx = blockIdx.x;
    const int gw = bx * 8 + wave, NGW = G * 8;
    unsigned char* ws = args.ws;
    const float* x = args.in[0]; const float* cvec = args.in[1]; const float* ctx = args.in[2]; const float* cctx = args.in[3];
    const float* w_ada = args.in[4]; const float* b_ada = args.in[5]; const float* norm1_g = args.in[6]; const float* w_in = args.in[7];
    const float* na_rpb = args.in[8]; const float* lbl = args.in[9]; const float* hg_g = args.in[10];
    const float* w_pa = args.in[11]; const float* w_pb = args.in[12]; const float* w_out = args.in[13]; const float* norm2_g = args.in[14];
    const float* w_f1 = args.in[15]; const float* w_f2 = args.in[16]; const float* final_g = args.in[17];
    float* out = args.out; unsigned char* outb = (unsigned char*)args.out;
    float* modall = (float*)(ws + WS_MOD); float* part = (float*)(ws + WS_PART);
    bf16* Wint = (bf16*)(ws + WS_WIN); bf16* Wpat = (bf16*)(ws + WS_WPA); bf16* Wpbt = (bf16*)(ws + WS_WPB); bf16* Woutt = (bf16*)(ws + WS_WOUT);
    bf16* Wf1t = (bf16*)(ws + WS_WF1); bf16* Wf2t = (bf16*)(ws + WS_WF2);
    bf16* UC1 = (bf16*)(ws + WS_UC1); bf16* KHC = (bf16*)(ws + WS_KHC); bf16* QKH = (bf16*)(ws + WS_QKH); bf16* VTC = (bf16*)(ws + WS_VTC); bf16* HC = (bf16*)(ws + WS_HC); bf16* U1 = (bf16*)(ws + WS_U1); bf16* VT = (bf16*)(ws + WS_VT);
    bf16* YM = (bf16*)(ws + WS_YM); bf16* H2 = (bf16*)(ws + WS_H2); bf16* HID = (bf16*)(ws + WS_HID);
    bf16* Hb = (bf16*)(outb + DO_H); bf16* ONA = (bf16*)(outb + DO_ONA); bf16* OF = (bf16*)(outb + DO_OF); bf16* OB = (bf16*)(ws + WS_OB); bf16* OHG = (bf16*)(outb + DO_OHG);
    const int lo = args.ph_lo, hi_ = args.ph_hi;
    if (tid < 64) ((LAS unsigned*)(lds + LDS_MISC))[tid] = 0u;
    __syncthreads();
    XcdBarrier xbar; xbar.bar = (unsigned*)(ws + WS_BAR); xbar.x = 0; xbar.st = nullptr;
    if (USE_XCD_BAR) xbar = xcd_barrier_post((unsigned*)(ws + WS_BAR), (volatile LAS unsigned*)(lds + LDS_MISC) + 8);
#define IN(k) (lo <= (k) && (k) < hi_)
#define SEAM(k) do { if (IN(k) && IN((k) + 1)) { if (!USE_XCD_BAR || lo < 0) grid.sync(); else xcd_barrier(xbar); } } while (0)

    if (IN(0)) {
        int lane = lane_k; asm volatile("" : "+v"(lane));
        LAS float* sv = (LAS float*)lds;
        for (int item = bx; item < 192; item += G) {
            const int kpart = item / 6, cgp = (item % 6) * 512 + tid;
            if (tid < 320) { const int v = tid >> 6, kk = tid & 63, kx = kpart * 64 + kk; const float cv = (v < 4) ? cvec[v * DM + kx] : cctx[kx]; sv[v * 64 + kk] = cv * sigm(cv); }
            __syncthreads();
            f32x4 acc[5];
#pragma unroll
            for (int v = 0; v < 5; ++v) acc[v] = (f32x4){0.f, 0.f, 0.f, 0.f};
            const float* wp = w_ada + (size_t)(kpart * 64) * NMOD + 4 * cgp;
#pragma unroll 4
            for (int kk = 0; kk < 64; ++kk) { const f32x4 w = __builtin_nontemporal_load((const f32x4*)(wp + (size_t)kk * NMOD));
#pragma unroll
                for (int v = 0; v < 5; ++v) acc[v] += w * sv[v * 64 + kk]; }
#pragma unroll
            for (int v = 0; v < 5; ++v) *(f32x4*)(part + (size_t)(kpart * 5 + v) * NMOD + 4 * cgp) = acc[v];
            __syncthreads();
        }
        LAS float* scr = (LAS float*)(lds + 4096 + wave * 16384);
        constexpr int I_IN = 32 * 384, I_PA = 16 * 64, I_OUT = 32 * 64, I_F1 = 32 * 352, I_F2 = 88 * 64;
        constexpr int NIT = I_IN + 2 * I_PA + I_OUT + I_F1 + I_F2;
        for (int it = gw; it < NIT; it += NGW) {
            int r = it;
            if (r < I_IN) { const int kb = r / 384, nb = r % 384, n0 = 32 * nb; transpose_item(w_in, DM, NIN, Wint, 64 * kb, n0, kInRowMap[n0 >> 10] + (n0 & 1023), scr, lane); continue; } r -= I_IN;
            if (r < I_PA) { const int kb = r / 64, nb = r % 64; transpose_item(w_pa, 1024, DM, Wpat, 64 * kb, 32 * nb, 32 * nb, scr, lane); continue; } r -= I_PA;
            if (r < I_PA) { const int kb = r / 64, nb = r % 64; transpose_item(w_pb, 1024, DM, Wpbt, 64 * kb, 32 * nb, 32 * nb, scr, lane); continue; } r -= I_PA;
            if (r < I_OUT) { const int kb = r / 64, nb = r % 64; transpose_item(w_out, DM, DM, Woutt, 64 * kb, 32 * nb, 32 * nb, scr, lane); continue; } r -= I_OUT;
            if (r < I_F1) { const int kb = r / 352, nb = r % 352, n0 = 32 * nb; const int isu = n0 >= FFH, j = n0 - isu * FFH;
                transpose_item(w_f1, DM, 2 * FFH, Wf1t, 64 * kb, n0, (j >> 7) * 256 + isu * 128 + (j & 127), scr, lane); continue; } r -= I_F1;
            { const int kb = r / 64, nb = r % 64; transpose_item(w_f2, FFH, DM, Wf2t, 64 * kb, 32 * nb, 32 * nb, scr, lane); }
        }
    }
    SEAM(0);
    if (IN(1)) {
        for (int i = bx * 512 + tid; i < 5 * NMOD; i += G * 512) { const int v = i / NMOD, n = i % NMOD; float s = b_ada[n];
            for (int kp = 0; kp < 32; ++kp) s += part[(size_t)(kp * 5 + v) * NMOD + n];
            modall[i] = s; }
    }
    SEAM(1);
    if (IN(2)) {
        int lane = lane_k; asm volatile("" : "+v"(lane));
        for (int m = 2 * gw; m < M + MC; m += 2 * NGW) {
            if (m < M) { const int b = m >> 13; norm_row2<true, false>(x + (size_t)m * DM, x + (size_t)(m + 1) * DM, norm1_g, modall + b * NMOD + DM, modall + b * NMOD, Hb + (size_t)m * DM, Hb + (size_t)(m + 1) * DM, nullptr, nullptr, lane); }
            else { const int mc = m - M; norm_row2<true, false>(ctx + (size_t)mc * DM, ctx + (size_t)(mc + 1) * DM, norm1_g, modall + 4 * NMOD + DM, modall + 4 * NMOD, HC + (size_t)mc * DM, HC + (size_t)(mc + 1) * DM, nullptr, nullptr, lane); }
        }
    }
    SEAM(2);
    if (IN(3)) {
        const bool fill = (G == 256);
        for (int gi = 0; gi < (fill ? 5 : 4); ++gi) {
            pg8::Gemm g; pg8::EpiStore E;
            if (gi == 4) { g = pg8::Gemm{Hb, Wint + (size_t)W_NOW * DM, M, 10240 - W_NOW, DM}; E = pg8::EpiStore{U1 + C_GA, U1W, nullptr, 0, 0, 0, 0, lbl, 0, 0}; }
            else if (gi == 0) { g = pg8::Gemm{Hb, Wint, M, W_NOW, DM}; E = pg8::EpiStore{U1, U1W, QKH, 1024, 3072, M, 0, lbl, 3072, 5120}; }
            else if (gi == 1) { g = pg8::Gemm{Wint + (size_t)10240 * DM, Hb, 2048, M, DM}; E = pg8::EpiStore{VT, 2048, nullptr, 0, 0, 0, 1, lbl, 0, 0}; }
            else if (gi == 2) { g = pg8::Gemm{HC, Wint + (size_t)2048 * DM, MC, 3072, DM}; E = pg8::EpiStore{UC1, UC1W, KHC, 0, 1024, MC, 0, lbl, 1024, 3072}; }
            else { g = pg8::Gemm{Wint + (size_t)10240 * DM, HC, 2048, MC, DM}; E = pg8::EpiStore{VTC, 2048, nullptr, 0, 0, 0, 1, lbl, 0, 0}; }
            pg8::StaticOrder S; S.init(g.M, g.N, G, (gi == 3 && G >= 128) ? (bx + G - 48) % G : bx);
            if (gi == 4) { if (bx >= 80) S.init2(g.M, g.N, G - 80, bx - 80, 0, GU_FILL); else S.init2(g.M, g.N, 1, 0, 0, 0); }
            pg8::gemm_phase<pg8::EpiStore, pg8::StaticOrder, true, true>(lds, g, S, E);
        }
    }
    SEAM(3);
    if (IN(4)) {
        const int nh = (G >= 128) ? 64 : 0;
        if (bx < nh || nh == 0) {
            for (int item = bx; item < 64; item += (nh ? nh : G)) hgrn_item(item, lbl, U1, UC1, VT, VTC, OF, OB, lds);
            if (nh) {
                pg8::Gemm g{Hb, Wint + (size_t)W_NOW * DM, M, 10240 - W_NOW, DM}; pg8::EpiStore E{U1 + C_GA, U1W, nullptr, 0, 0, 0, 0, lbl, 0, 0};
                pg8::StaticOrder S; S.init2(g.M, g.N, nh, bx, (G == 256) ? GU_SPLIT2 : GU_SPLIT, 1 << 30);
                pg8::gemm_phase<pg8::EpiStore, pg8::StaticOrder, true, true>(lds, g, S, E);
            }
        }
        if (bx >= nh) {
            int lane = lane_k; asm volatile("" : "+v"(lane));
            LAS float* rpb = (LAS float*)lds;
            for (int i = tid; i < RPB_FLOATS; i += 512) { const int j = i - RPB_OFF; rpb[i] = (i >= RPB_NINF) ? -INFINITY : (j >= 0 && j < 16 * 15 * 31) ? na_rpb[j] * LOG2E : 0.f; }
            __syncthreads();
            const int nwv = (G - nh) * 8;
            for (int task = (bx - nh) * 8 + wave; task < 16384; task += nwv) na_task(task, QKH, KHC, VT, VTC, ONA, rpb, (LAS float*)(lds + 32768 + wave * 8192), lane);
            __syncthreads();
            pg8::Gemm g{Hb, Wint + (size_t)W_NOW * DM, M, 10240 - W_NOW, DM}; pg8::EpiStore E{U1 + C_GA, U1W, nullptr, 0, 0, 0, 0, lbl, 0, 0};
            pg8::StaticOrder S; S.init2(g.M, g.N, G - nh, bx - nh, (G == 256) ? GU_FILL : 0, nh ? ((G == 256) ? GU_SPLIT2 : GU_SPLIT) : (1 << 30));
            pg8::gemm_phase<pg8::EpiStore, pg8::StaticOrder, true, true>(lds, g, S, E);
        }
    }
    SEAM(4);
    if (IN(5)) {
        int lane = lane_k; asm volatile("" : "+v"(lane));
        for (int m = gw; m < M; m += NGW) {
            const size_t o = (size_t)m * 1024 + 16 * lane;
            const u32x4 a0 = __builtin_nontemporal_load((const u32x4*)(OF + o)), a1 = __builtin_nontemporal_load((const u32x4*)(OF + o + 8)), b0 = __builtin_nontemporal_load((const u32x4*)(OB + o)), b1 = __builtin_nontemporal_load((const u32x4*)(OB + o + 8));
            const u32x4 g0 = *(const u32x4*)(U1 + (size_t)m * U1W + C_HOG + 16 * lane), g1 = *(const u32x4*)(U1 + (size_t)m * U1W + C_HOG + 16 * lane + 8);
            float v[16], gg[16];
#pragma unroll
            for (int i = 0; i < 4; ++i) { v[2 * i] = pg8::bflo(a0[i]) + pg8::bflo(b0[i]); v[2 * i + 1] = pg8::bfhi(a0[i]) + pg8::bfhi(b0[i]);
                v[8 + 2 * i] = pg8::bflo(a1[i]) + pg8::bflo(b1[i]); v[8 + 2 * i + 1] = pg8::bfhi(a1[i]) + pg8::bfhi(b1[i]);
                gg[2 * i] = pg8::bflo(g0[i]); gg[2 * i + 1] = pg8::bfhi(g0[i]); gg[8 + 2 * i] = pg8::bflo(g1[i]); gg[8 + 2 * i + 1] = pg8::bfhi(g1[i]); }
            float ss = 0.f;
#pragma unroll
            for (int i = 0; i < 16; ++i) ss += v[i] * v[i];
            ss += __shfl_xor(ss, 1); ss += __shfl_xor(ss, 2); ss += __shfl_xor(ss, 4);
            const float rstd = 1.0f / sqrtf(ss * (1.0f / 128.0f) + EPS);
            const float* gp = hg_g + 16 * (lane & 7);
            float y[16];
#pragma unroll
            for (int i = 0; i < 16; ++i) y[i] = v[i] * rstd * gp[i] * (gg[i] * pg8::sigm(gg[i]));
            u32x4 w0, w1; w0.x = pk2(y[0], y[1]); w0.y = pk2(y[2], y[3]); w0.z = pk2(y[4], y[5]); w0.w = pk2(y[6], y[7]);
            w1.x = pk2(y[8], y[9]); w1.y = pk2(y[10], y[11]); w1.z = pk2(y[12], y[13]); w1.w = pk2(y[14], y[15]);
            *(u32x4*)(OHG + o) = w0; *(u32x4*)(OHG + o + 8) = w1;
        }
    }
    SEAM(5);
    if (IN(6)) {
        for (int gi = 0; gi < 2; ++gi) {
            pg8::Gemm g = gi ? pg8::Gemm{OHG, Wpbt, M, DM, 1024} : pg8::Gemm{ONA, Wpat, M, DM, 1024};
            pg8::EpiMerge E{YM, DM, U1 + (gi ? C_GB : C_GA), U1W, gi};
            pg8::StaticOrder S; S.init(M, DM, G, bx);
            pg8::gemm_phase<pg8::EpiMerge, pg8::StaticOrder, true, true>(lds, g, S, E);
        }
    }
    SEAM(6);
    if (IN(7)) {
        pg8::Gemm g{YM, Woutt, M, DM, DM}; pg8::EpiRes E{x, out, modall + 2 * DM};
        pg8::StaticOrder S; S.init(M, DM, G, bx);
        pg8::gemm_phase<pg8::EpiRes, pg8::StaticOrder, true, true>(lds, g, S, E);
    }
    SEAM(7);
    if (IN(8)) {
        int lane = lane_k; asm volatile("" : "+v"(lane));
        for (int m = 2 * gw; m < M; m += 2 * NGW) { const int b = m >> 13; norm_row2<false, false>(out + (size_t)m * DM, out + (size_t)(m + 1) * DM, norm2_g, modall + b * NMOD + 4 * DM, modall + b * NMOD + 3 * DM, H2 + (size_t)m * DM, H2 + (size_t)(m + 1) * DM, nullptr, nullptr, lane); }
    }
    SEAM(8);
    if (IN(9)) {
        pg8::Gemm g{H2, Wf1t, M, 2 * FFH, DM}; pg8::EpiSwiglu E{HID, FFH};
        pg8::StaticOrder S; S.init(M, 2 * FFH, G, bx);
        pg8::gemm_phase<pg8::EpiSwiglu, pg8::StaticOrder, true, true>(lds, g, S, E);
    }
    SEAM(9);
    if (IN(10)) {
        pg8::Gemm g{HID, Wf2t, M, DM, FFH}; pg8::EpiRes E{out, out, modall + 5 * DM};
        pg8::StaticOrder S; S.init(M, DM, G, bx);
        pg8::gemm_phase<pg8::EpiRes, pg8::StaticOrder, true, true>(lds, g, S, E);
    }
    SEAM(10);
    if (IN(11)) {
        int lane = lane_k; asm volatile("" : "+v"(lane));
        for (int m = 2 * gw; m < M; m += 2 * NGW) norm_row2<false, true>(out + (size_t)m * DM, out + (size_t)(m + 1) * DM, final_g, nullptr, nullptr, nullptr, nullptr, out + (size_t)m * DM, out + (size_t)(m + 1) * DM, lane);
    }
#undef IN
#undef SEAM
}

#ifndef MK_SPLIT
#define MK_SPLIT 0
#endif
extern "C" void kernel_launch(void* const* d_in, const int* in_sizes, int n_in, void* d_out, int out_size, void* d_ws, size_t ws_size, hipStream_t stream) {
    static int grid = 0;
    if (grid == 0) {
        if (n_in != 18 || out_size != M * DM || ws_size < WS_END) { fprintf(stderr, "kernel_launch: unexpected shapes (n_in %d out %d ws %zu)\n", n_in, out_size, ws_size); grid = -1; return; }
        int dev = 0, cus = 0, per_cu = 0;
        (void)hipGetDevice(&dev); (void)hipDeviceGetAttribute(&cus, hipDeviceAttributeMultiprocessorCount, dev);
        if (hipFuncSetAttribute((const void*)fwd_mega, hipFuncAttributeMaxDynamicSharedMemorySize, LDS_BYTES) != hipSuccess) { fprintf(stderr, "kernel_launch: hipFuncSetAttribute failed\n"); grid = -1; return; }
        if (hipOccupancyMaxActiveBlocksPerMultiprocessor(&per_cu, (const void*)fwd_mega, 512, LDS_BYTES) != hipSuccess || per_cu < 1) { fprintf(stderr, "kernel_launch: occupancy query says %d\n", per_cu); per_cu = 1; }
        (void)hipGetLastError();
        grid = cus * per_cu;
        fprintf(stderr, "kernel_launch: grid %d (cus %d x %d), ws %zu\n", grid, cus, per_cu, ws_size);
    }
    if (grid < 0) return;
    if (USE_XCD_BAR && hipMemsetAsync((char*)d_ws + WS_BAR, 0, BAR_BYTES, stream) != hipSuccess) { fprintf(stderr, "kernel_launch: hipMemsetAsync of the barrier words failed\n"); return; }
    Args a{};
    for (int i = 0; i < 18; ++i) a.in[i] = (const float*)d_in[i];
    a.out = (float*)d_out; a.ws = (unsigned char*)d_ws;
#if MK_SPLIT
    for (int p = 0; p < NPH; ++p) { a.ph_lo = p; a.ph_hi = p + 1; void* kargs[] = {&a};
        hipError_t e = hipLaunchCooperativeKernel((const void*)fwd_mega, dim3(grid), dim3(512), kargs, LDS_BYTES, stream);
        if (e != hipSuccess) { fprintf(stderr, "kernel_launch: launch %d failed: %s\n", p, hipGetErrorString(e)); break; } }
#else
    a.ph_lo = 0; a.ph_hi = NPH; void* kargs[] = {&a};
    hipError_t e = hipLaunchCooperativeKernel((const void*)fwd_mega, dim3(grid), dim3(512), kargs, LDS_BYTES, stream);
    if (e != hipSuccess) fprintf(stderr, "kernel_launch: cooperative launch failed: %s (grid %d)\n", hipGetErrorString(e), grid);
#endif
}
```
